# Optimizing an MI355X kernel written in HIP

```python
import jax, jax.numpy as jnp
from jax import lax
import numpy as np

D_MODEL = 1024
BATCH = 8
SEQ = 2048
DEPTH = 2

PLE_DIM = 256
SC_WIDTH = 512
SC_KERNEL = 3
N_HEADS = 8
QK_NOPE = 64
QK_ROPE = 32
V_HEAD = 64
Q_LORA = 768
KV_LORA = 256
ROPE_THETA = 10000.0
Q_BLOCK = 128
CONF_WIDTH = 512
CONF_KERNEL = 31
N_GROUPS = 4
EXPERTS_PER_GROUP = 8
N_EXPERTS = N_GROUPS * EXPERTS_PER_GROUP
TOP_K = 2
EXPERT_HIDDEN = 256
EPS = 1e-6

SPLIT_SIZES = (D_MODEL, D_MODEL, D_MODEL,
               SC_WIDTH, SC_WIDTH, SC_WIDTH,
               Q_LORA, KV_LORA, QK_ROPE,
               CONF_WIDTH, CONF_WIDTH)
IN_COLS = 3 * D_MODEL + 3 * SC_WIDTH + Q_LORA + KV_LORA + QK_ROPE + 2 * CONF_WIDTH

kernel_name = 'hybrid_gated_sconv_mla_conformer_hmoe'


def rms_norm(x, g):
    x32 = x.astype(jnp.float32)
    y = x32 * lax.rsqrt(jnp.mean(x32 * x32, axis=-1, keepdims=True) + EPS) * g.astype(jnp.float32)
    return y.astype(x.dtype)


def layer_norm(x, g, b):
    x32 = x.astype(jnp.float32)
    mu = jnp.mean(x32, axis=-1, keepdims=True)
    xc = x32 - mu
    var = jnp.mean(xc * xc, axis=-1, keepdims=True)
    y = xc * lax.rsqrt(var + EPS) * g.astype(jnp.float32) + b.astype(jnp.float32)
    return y.astype(x.dtype)


def causal_depthwise_conv(x, w):
    k, c = w.shape
    return lax.conv_general_dilated(x, w[:, None, :], window_strides=(1,), padding=[(k - 1, 0)],
                                    dimension_numbers=('NWC', 'WIO', 'NWC'), feature_group_count=c)


def rope_cos_sin(positions, dim):
    inv_freq = ROPE_THETA ** (-jnp.arange(0, dim, 2, dtype=jnp.float32) / dim)
    ang = positions.astype(jnp.float32)[..., None] * inv_freq
    return jnp.cos(ang), jnp.sin(ang)


def apply_rope(x, cos, sin):
    half = x.shape[-1] // 2
    x1, x2 = x[..., :half], x[..., half:]
    c, s = cos.astype(x.dtype), sin.astype(x.dtype)
    return jnp.concatenate([x1 * c - x2 * s, x1 * s + x2 * c], axis=-1)


def mla_attention(q_nope, q_rope, k_nope, k_rope, v):
    b, s, h, _ = q_nope.shape
    nblk = s // Q_BLOCK
    scale = (QK_NOPE + QK_ROPE) ** -0.5
    k_idx = jnp.arange(s)

    def to_blocks(t):
        return jnp.moveaxis(t.reshape(b, nblk, Q_BLOCK, *t.shape[2:]), 1, 0)

    def one_block(args):
        qn, qr, blk = args
        sc = (jnp.einsum('bqhd,bkhd->bhqk', qn, k_nope)
              + jnp.einsum('bqhr,bkr->bhqk', qr, k_rope)).astype(jnp.float32) * scale
        q_idx = blk * Q_BLOCK + jnp.arange(Q_BLOCK)
        causal = q_idx[:, None] >= k_idx[None, :]
        sc = jnp.where(causal, sc, -jnp.inf)
        pr = jax.nn.softmax(sc, axis=-1).astype(v.dtype)
        return jnp.einsum('bhqk,bkhd->bqhd', pr, v)

    out = lax.map(one_block, (to_blocks(q_nope), to_blocks(q_rope), jnp.arange(nblk)))
    return jnp.moveaxis(out, 0, 1).reshape(b, s, h * V_HEAD)


def mixer_block(xn, cos, sin, w_in, conv_a_w, w_out_a, q_norm_g, w_uq, kv_norm_g, w_ukv, w_out_b,
                conv_c_w, ln_c_g, ln_c_b, w_out_c, w_o):
    b, s, _ = xn.shape
    proj = xn @ w_in
    points, acc = [], 0
    for size in SPLIT_SIZES[:-1]:
        acc += size
        points.append(acc)
    (gate_a, gate_b, gate_c, sc_b, sc_c, sc_u, q_lat, kv_lat, k_rope_raw,
     glu_val, glu_gate) = jnp.split(proj, points, axis=-1)

    y_a = (sc_b * causal_depthwise_conv(sc_c * sc_u, conv_a_w)) @ w_out_a

    q = (rms_norm(q_lat, q_norm_g) @ w_uq).reshape(b, s, N_HEADS, QK_NOPE + QK_ROPE)
    q_nope = q[..., :QK_NOPE]
    q_rope = apply_rope(q[..., QK_NOPE:], cos[:, :, None, :], sin[:, :, None, :])
    kv = (rms_norm(kv_lat, kv_norm_g) @ w_ukv).reshape(b, s, N_HEADS, QK_NOPE + V_HEAD)
    k_nope, v = kv[..., :QK_NOPE], kv[..., QK_NOPE:]
    k_rope = apply_rope(k_rope_raw, cos, sin)
    y_b = mla_attention(q_nope, q_rope, k_nope, k_rope, v) @ w_out_b

    u = glu_val * jax.nn.sigmoid(glu_gate)
    u = causal_depthwise_conv(u, conv_c_w)
    u = jax.nn.silu(layer_norm(u, ln_c_g, ln_c_b))
    y_c = u @ w_out_c

    merged = (jax.nn.sigmoid(gate_a) * y_a + jax.nn.sigmoid(gate_b) * y_b
              + jax.nn.sigmoid(gate_c) * y_c)
    return merged @ w_o


def hier_moe(xn, w_rg, b_rg, w_re, b_re, w_gate, w_up, w_down):
    b, s, _ = xn.shape
    grp_logits = (xn @ w_rg).astype(jnp.float32) + b_rg.astype(jnp.float32)
    pg = jax.nn.softmax(grp_logits, axis=-1)
    g_sel = jnp.argmax(grp_logits, axis=-1)
    g_onehot = jax.nn.one_hot(g_sel, N_GROUPS, dtype=jnp.float32)
    p_sel = jnp.max(pg, axis=-1, keepdims=True)
    exp_logits = ((xn @ w_re).astype(jnp.float32) + b_re.astype(jnp.float32)).reshape(
        b, s, N_GROUPS, EXPERTS_PER_GROUP)
    exp_sel = jnp.sum(exp_logits * g_onehot[..., None], axis=2)
    pe = jax.nn.softmax(exp_sel, axis=-1)
    top_w, top_i = lax.top_k(pe, TOP_K)
    top_w = top_w / jnp.sum(top_w, axis=-1, keepdims=True) * p_sel
    comb_in = jnp.sum(jax.nn.one_hot(top_i, EXPERTS_PER_GROUP, dtype=jnp.float32) * top_w[..., None], axis=-2)
    comb = (g_onehot[..., None] * comb_in[:, :, None, :]).astype(xn.dtype)
    y = jnp.zeros_like(xn)
    for g in range(N_GROUPS):
        sl = slice(g * EXPERTS_PER_GROUP, (g + 1) * EXPERTS_PER_GROUP)
        hg = jnp.einsum('bsd,edf->bsef', xn, w_gate[sl])
        hu = jnp.einsum('bsd,edf->bsef', xn, w_up[sl])
        hh = jax.nn.silu(hg) * hu * comb[:, :, g, :, None]
        y = y + jnp.einsum('bsef,efd->bsd', hh, w_down[sl])
    return y


def setup_inputs(seed: int = 0) -> dict:
    key = jax.random.key(seed)
    ks = iter(jax.random.split(key, 40))

    def w(shape, fan_in):
        return jax.random.normal(next(ks), shape, jnp.float32) * fan_in ** -0.5

    def gain(shape):
        return 1.0 + 0.02 * jax.random.normal(next(ks), shape, jnp.float32)

    def small(shape, scale):
        return scale * jax.random.normal(next(ks), shape, jnp.float32)

    L = DEPTH
    x = jax.random.normal(next(ks), (BATCH, SEQ, D_MODEL), jnp.float32)
    p = jax.random.normal(next(ks), (DEPTH, BATCH, SEQ, PLE_DIM), jnp.float32)
    start = jax.random.randint(next(ks), (BATCH, 1), 0, 1024, dtype=jnp.int32)
    positions = start + jnp.arange(SEQ, dtype=jnp.int32)[None, :]
    return {
        'x': x, 'p': p, 'positions': positions,
        'ln_mix_g': gain((L, D_MODEL)),
        'w_in': w((L, D_MODEL, IN_COLS), D_MODEL),
        'conv_a_w': w((L, SC_KERNEL, SC_WIDTH), SC_KERNEL),
        'w_out_a': w((L, SC_WIDTH, D_MODEL), SC_WIDTH),
        'q_norm_g': gain((L, Q_LORA)),
        'w_uq': w((L, Q_LORA, N_HEADS * (QK_NOPE + QK_ROPE)), Q_LORA),
        'kv_norm_g': gain((L, KV_LORA)),
        'w_ukv': w((L, KV_LORA, N_HEADS * (QK_NOPE + V_HEAD)), KV_LORA),
        'w_out_b': w((L, N_HEADS * V_HEAD, D_MODEL), N_HEADS * V_HEAD),
        'conv_c_w': w((L, CONF_KERNEL, CONF_WIDTH), CONF_KERNEL),
        'ln_c_g': gain((L, CONF_WIDTH)),
        'ln_c_b': small((L, CONF_WIDTH), 0.02),
        'w_out_c': w((L, CONF_WIDTH, D_MODEL), CONF_WIDTH),
        'w_o': w((L, D_MODEL, D_MODEL), D_MODEL),
        'ln_ffn_g': gain((L, D_MODEL)),
        'w_route_grp': w((L, D_MODEL, N_GROUPS), D_MODEL),
        'b_route_grp': small((L, N_GROUPS), 0.01),
        'w_route_exp': w((L, D_MODEL, N_EXPERTS), D_MODEL),
        'b_route_exp': small((L, N_EXPERTS), 0.01),
        'w_exp_gate': w((L, N_EXPERTS, D_MODEL, EXPERT_HIDDEN), D_MODEL),
        'w_exp_up': w((L, N_EXPERTS, D_MODEL, EXPERT_HIDDEN), D_MODEL),
        'w_exp_down': w((L, N_EXPERTS, EXPERT_HIDDEN, D_MODEL), EXPERT_HIDDEN),
        'ln_ple_g': gain((L, D_MODEL)),
        'w_ple_gate': w((L, D_MODEL, D_MODEL), D_MODEL),
        'w_ple': w((L, PLE_DIM, D_MODEL), PLE_DIM),
        'final_norm_g': gain((D_MODEL,)),
    }


def reference(x, p, positions, ln_mix_g, w_in, conv_a_w, w_out_a, q_norm_g, w_uq, kv_norm_g, w_ukv,
              w_out_b, conv_c_w, ln_c_g, ln_c_b, w_out_c, w_o, ln_ffn_g, w_route_grp, b_route_grp,
              w_route_exp, b_route_exp, w_exp_gate, w_exp_up, w_exp_down, ln_ple_g, w_ple_gate, w_ple,
              final_norm_g):
    cos, sin = rope_cos_sin(positions, QK_ROPE)
    for i in range(DEPTH):
        h = rms_norm(x, ln_mix_g[i])
        x = x + mixer_block(h, cos, sin, w_in[i], conv_a_w[i], w_out_a[i], q_norm_g[i], w_uq[i],
                            kv_norm_g[i], w_ukv[i], w_out_b[i], conv_c_w[i], ln_c_g[i], ln_c_b[i],
                            w_out_c[i], w_o[i])
        h = rms_norm(x, ln_ffn_g[i])
        x = x + hier_moe(h, w_route_grp[i], b_route_grp[i], w_route_exp[i], b_route_exp[i],
                         w_exp_gate[i], w_exp_up[i], w_exp_down[i])
        h = rms_norm(x, ln_ple_g[i])
        x = x + jax.nn.sigmoid(h @ w_ple_gate[i]) * (p[i] @ w_ple[i])
    return rms_norm(x, final_norm_g)
```

```cpp
#include <hip/hip_runtime.h>
#include <cstdint>
#include <cstdio>

namespace nv {
constexpr int D = 1024, NB = 8, S = 2048, M = NB * S, DEPTH = 2;
constexpr int INC = 6688;
constexpr int O_GA = 0, O_GB = 1024, O_GC = 2048, O_SCB = 3072, O_SCC = 3584, O_SCU = 4096, O_QL = 4608, O_KVL = 5376, O_KR = 5632, O_GV = 5664, O_GG = 6176;
constexpr float EPS = 1e-6f;
constexpr int MC = 4096;

__device__ __forceinline__ float sigmoidf_(float v) { return 1.f / (1.f + expf(-v)); }
__device__ __forceinline__ float wave_sum(float v) {
#pragma unroll
    for (int o = 1; o < 64; o <<= 1) v += __shfl_xor(v, o);
    return v;
}
__device__ __forceinline__ float wave_max(float v) {
#pragma unroll
    for (int o = 1; o < 64; o <<= 1) v = fmaxf(v, __shfl_xor(v, o));
    return v;
}
template <int NW> __device__ __forceinline__ float block_sum(float v, float* red) {
    v = wave_sum(v);
    __syncthreads();
    if ((threadIdx.x & 63) == 0) red[threadIdx.x >> 6] = v;
    __syncthreads();
    float t = 0.f;
#pragma unroll
    for (int i = 0; i < NW; ++i) t += red[i];
    return t;
}

struct EStore { float* C; long long ldc; __device__ void operator()(int r, int c, float v) const { C[(size_t)r * ldc + c] = v; } };
struct EAdd { float* C; long long ldc; __device__ void operator()(int r, int c, float v) const { C[(size_t)r * ldc + c] += v; } };
struct EGateSet { float* C; long long ldc; const float* G; long long ldg; __device__ void operator()(int r, int c, float v) const { C[(size_t)r * ldc + c] = sigmoidf_(G[(size_t)r * ldg + c]) * v; } };
struct EGateAdd { float* C; long long ldc; const float* G; long long ldg; __device__ void operator()(int r, int c, float v) const { C[(size_t)r * ldc + c] += sigmoidf_(G[(size_t)r * ldg + c]) * v; } };

template <class Epi> __global__ void __launch_bounds__(256) gemm(const float* __restrict__ A, long long lda_, const float* __restrict__ Bm, long long ldb_, long long N_, long long K_, Epi epi) {
    const int lda = (int)lda_, ldb = (int)ldb_, N = (int)N_, K = (int)K_;
    __shared__ float As[16][132];
    __shared__ float Bs[16][132];
    const int tid = threadIdx.x, tx = tid & 15, ty = tid >> 4;
    const int m0 = blockIdx.y * 128, n0 = blockIdx.x * 128;
    float acc[8][8];
#pragma unroll
    for (int i = 0; i < 8; ++i)
#pragma unroll
        for (int j = 0; j < 8; ++j) acc[i][j] = 0.f;
    for (int k0 = 0; k0 < K; k0 += 16) {
#pragma unroll
        for (int i = 0; i < 2; ++i) {
            const int idx = tid + i * 256, r = idx >> 2, kq = idx & 3;
            const float4 v = *(const float4*)(A + (size_t)(m0 + r) * lda + k0 + kq * 4);
            As[kq * 4 + 0][r] = v.x; As[kq * 4 + 1][r] = v.y; As[kq * 4 + 2][r] = v.z; As[kq * 4 + 3][r] = v.w;
        }
#pragma unroll
        for (int i = 0; i < 2; ++i) {
            const int idx = tid + i * 256, kk = idx >> 5, nq = idx & 31, n = n0 + nq * 4;
            float4 v = make_float4(0.f, 0.f, 0.f, 0.f);
            if (n < N) v = *(const float4*)(Bm + (size_t)(k0 + kk) * ldb + n);
            *(float4*)&Bs[kk][nq * 4] = v;
        }
        __syncthreads();
#pragma unroll
        for (int kk = 0; kk < 16; ++kk) {
            const float4 a0 = *(const float4*)&As[kk][ty * 4], a1 = *(const float4*)&As[kk][64 + ty * 4];
            const float4 b0 = *(const float4*)&Bs[kk][tx * 4], b1 = *(const float4*)&Bs[kk][64 + tx * 4];
            const float a[8] = {a0.x, a0.y, a0.z, a0.w, a1.x, a1.y, a1.z, a1.w};
            const float b[8] = {b0.x, b0.y, b0.z, b0.w, b1.x, b1.y, b1.z, b1.w};
#pragma unroll
            for (int i = 0; i < 8; ++i)
#pragma unroll
                for (int j = 0; j < 8; ++j) acc[i][j] = fmaf(a[i], b[j], acc[i][j]);
        }
        __syncthreads();
    }
#pragma unroll
    for (int i = 0; i < 8; ++i)
#pragma unroll
        for (int j = 0; j < 8; ++j) {
            const int r = m0 + (i < 4 ? ty * 4 + i : 64 + ty * 4 + (i - 4));
            const int c = n0 + (j < 4 ? tx * 4 + j : 64 + tx * 4 + (j - 4));
            if (c < N) epi(r, c, acc[i][j]);
        }
}
template <class Epi> static void launch_gemm(hipStream_t st, const float* A, int lda, const float* Bm, int ldb, int rows, int N, int K, Epi e) {
    dim3 grid((N + 127) / 128, rows / 128);
    hipLaunchKernelGGL(gemm<Epi>, grid, dim3(256), 0, st, A, (long long)lda, Bm, (long long)ldb, (long long)N, (long long)K, e);
}

__global__ void __launch_bounds__(256) rmsnorm_rows(const float* in, long long ldi_, long long ncols_, const float* g, float* out, long long ldo_) {
    const int ldi = (int)ldi_, ncols = (int)ncols_, ldo = (int)ldo_;
    __shared__ float red[4];
    const int row = blockIdx.x;
    const float* x = in + (size_t)row * ldi;
    float ss = 0.f;
    for (int c = threadIdx.x; c < ncols; c += 256) { const float v = x[c]; ss += v * v; }
    ss = block_sum<4>(ss, red);
    const float r = 1.0f / sqrtf(ss / (float)ncols + EPS);
    for (int c = threadIdx.x; c < ncols; c += 256) out[(size_t)row * ldo + c] = x[c] * r * g[c];
}

__global__ void __launch_bounds__(512) mixa_prep(const float* P, const float* w  , float* out  ) {
    const int row = blockIdx.x, c = threadIdx.x, t = row % S;
    float a = 0.f;
#pragma unroll
    for (int k = 0; k < 3; ++k) {
        const int tt = t - 2 + k;
        if (tt >= 0) { const float* pr = P + (size_t)(row - 2 + k) * INC; a += w[k * 512 + c] * (pr[O_SCC + c] * pr[O_SCU + c]); }
    }
    out[(size_t)row * 512 + c] = P[(size_t)row * INC + O_SCB + c] * a;
}
__global__ void __launch_bounds__(512) mixc_prep(const float* P, const float* w  , const float* g, const float* bta, float* out) {
    __shared__ float red[8];
    const int row = blockIdx.x, c = threadIdx.x, t = row % S;
    float v = 0.f;
    for (int k = 0; k < 31; ++k) {
        const int tt = t - 30 + k;
        if (tt >= 0) { const float* pr = P + (size_t)(row - 30 + k) * INC; v += w[k * 512 + c] * (pr[O_GV + c] * sigmoidf_(pr[O_GG + c])); }
    }
    const float mean = block_sum<8>(v, red) * (1.f / 512.f);
    const float d = v - mean;
    const float var = block_sum<8>(d * d, red) * (1.f / 512.f);
    const float y = d * (1.0f / sqrtf(var + EPS)) * g[c] + bta[c];
    out[(size_t)row * 512 + c] = y * sigmoidf_(y);
}
__global__ void __launch_bounds__(256) rope_q(float* Q, const int* pos  ) {
    const int idx = blockIdx.x * 256 + threadIdx.x;
    const int i = idx & 15, h = (idx >> 4) & 7, row = idx >> 7;
    const double ang = (double)pos[row] * pow(10000.0, -(double)i / 16.0);
    const float cs = (float)cos(ang), sn = (float)sin(ang);
    float* q = Q + (size_t)row * 768 + h * 96 + 64;
    const float x1 = q[i], x2 = q[16 + i];
    q[i] = x1 * cs - x2 * sn; q[16 + i] = x1 * sn + x2 * cs;
}
__global__ void __launch_bounds__(256) rope_k(const float* P, float* KR, const int* pos) {
    const int idx = blockIdx.x * 256 + threadIdx.x;
    const int i = idx & 15, row = idx >> 4;
    const double ang = (double)pos[row] * pow(10000.0, -(double)i / 16.0);
    const float cs = (float)cos(ang), sn = (float)sin(ang);
    const float* p = P + (size_t)row * INC + O_KR;
    const float x1 = p[i], x2 = p[16 + i];
    KR[(size_t)row * 32 + i] = x1 * cs - x2 * sn; KR[(size_t)row * 32 + 16 + i] = x1 * sn + x2 * cs;
}
__global__ void __launch_bounds__(64) attn(const float* Q, const float* KV, const float* KR, float* AO) {
    __shared__ float sc[S];
    __shared__ float qs[96];
    const int q = blockIdx.x, h = blockIdx.y, b = blockIdx.z, lane = threadIdx.x;
    const size_t base = (size_t)b * S;
    for (int i = lane; i < 96; i += 64) qs[i] = Q[(base + q) * 768 + h * 96 + i];
    __syncthreads();
    const float scale = 1.0f / sqrtf(96.0f);
    float mx = -INFINITY;
    for (int j = lane; j <= q; j += 64) {
        const float4* kn = (const float4*)(KV + (base + j) * 1024 + h * 128);
        const float4* kr = (const float4*)(KR + (base + j) * 32);
        float s = 0.f;
#pragma unroll
        for (int d4 = 0; d4 < 16; ++d4) { const float4 k = kn[d4]; s += k.x * qs[4 * d4] + k.y * qs[4 * d4 + 1] + k.z * qs[4 * d4 + 2] + k.w * qs[4 * d4 + 3]; }
#pragma unroll
        for (int d4 = 0; d4 < 8; ++d4) { const float4 k = kr[d4]; s += k.x * qs[64 + 4 * d4] + k.y * qs[64 + 4 * d4 + 1] + k.z * qs[64 + 4 * d4 + 2] + k.w * qs[64 + 4 * d4 + 3]; }
        s *= scale; sc[j] = s; mx = fmaxf(mx, s);
    }
    mx = wave_max(mx);
    float sum = 0.f;
    for (int j = lane; j <= q; j += 64) { const float p = expf(sc[j] - mx); sc[j] = p; sum += p; }
    sum = wave_sum(sum);
    __syncthreads();
    float o = 0.f;
    const float* vp = KV + base * 1024 + h * 128 + 64 + lane;
    for (int j = 0; j <= q; ++j) o += sc[j] * vp[(size_t)j * 1024];
    AO[(base + q) * 512 + h * 64 + lane] = o / sum;
}
__global__ void __launch_bounds__(64) route(const float* HN, const float* wrg, const float* brg, const float* wre, const float* bre, int* sel, float* wts) {
    const int row = blockIdx.x, lane = threadIdx.x;
    float acc[36];
#pragma unroll
    for (int c = 0; c < 36; ++c) acc[c] = 0.f;
    for (int k = lane; k < D; k += 64) {
        const float x = HN[(size_t)row * D + k];
#pragma unroll
        for (int c = 0; c < 4; ++c) acc[c] += x * wrg[k * 4 + c];
#pragma unroll
        for (int c = 0; c < 32; ++c) acc[4 + c] += x * wre[k * 32 + c];
    }
#pragma unroll
    for (int c = 0; c < 36; ++c) acc[c] = wave_sum(acc[c]);
    if (lane == 0) {
        float gl[4]; float gm = -INFINITY; int gs = 0;
#pragma unroll
        for (int c = 0; c < 4; ++c) { gl[c] = acc[c] + brg[c]; if (gl[c] > gm) { gm = gl[c]; gs = c; } }
        float gsum = 0.f;
#pragma unroll
        for (int c = 0; c < 4; ++c) gsum += expf(gl[c] - gm);
        const float p_sel = 1.0f / gsum;
        float el[8]; float em = -INFINITY;
#pragma unroll
        for (int e = 0; e < 8; ++e) {
            float v = 0.f;
#pragma unroll
            for (int g = 0; g < 4; ++g) if (g == gs) v = acc[4 + g * 8 + e] + bre[g * 8 + e];
            el[e] = v; em = fmaxf(em, v);
        }
        float esum = 0.f; float pe[8];
#pragma unroll
        for (int e = 0; e < 8; ++e) { pe[e] = expf(el[e] - em); esum += pe[e]; }
        int i0 = 0; float p0 = -1.f;
#pragma unroll
        for (int e = 0; e < 8; ++e) { pe[e] /= esum; if (pe[e] > p0) { p0 = pe[e]; i0 = e; } }
        int i1 = 0; float p1 = -1.f;
#pragma unroll
        for (int e = 0; e < 8; ++e) if (e != i0 && pe[e] > p1) { p1 = pe[e]; i1 = e; }
        const float tot = p0 + p1;
        sel[row * 2 + 0] = gs * 8 + i0; sel[row * 2 + 1] = gs * 8 + i1;
        wts[row * 2 + 0] = p0 / tot * p_sel; wts[row * 2 + 1] = p1 / tot * p_sel;
    }
}
__global__ void __launch_bounds__(256) moe_tok(const float* HN, const int* sel, const float* wts, const float* Wg, const float* Wu, const float* Wd, float* X) {
    __shared__ float xs[D];
    __shared__ float hh[256];
    const int row = blockIdx.x, j = threadIdx.x;
    for (int k = j; k < D; k += 256) xs[k] = HN[(size_t)row * D + k];
    __syncthreads();
    float y[4] = {0.f, 0.f, 0.f, 0.f};
    for (int s = 0; s < 2; ++s) {
        const int e = sel[row * 2 + s]; const float w = wts[row * 2 + s];
        const float* wg = Wg + (size_t)e * D * 256 + j; const float* wu = Wu + (size_t)e * D * 256 + j;
        float g = 0.f, u = 0.f;
        for (int k = 0; k < D; ++k) { const float x = xs[k]; g += x * wg[(size_t)k * 256]; u += x * wu[(size_t)k * 256]; }
        __syncthreads();
        hh[j] = g * sigmoidf_(g) * u * w;
        __syncthreads();
        const float* wd = Wd + (size_t)e * 256 * D;
        for (int f = 0; f < 256; ++f) { const float hv = hh[f];
#pragma unroll
            for (int dd = 0; dd < 4; ++dd) y[dd] += hv * wd[(size_t)f * D + j + 256 * dd]; }
    }
#pragma unroll
    for (int dd = 0; dd < 4; ++dd) X[(size_t)row * D + j + 256 * dd] += y[dd];
}
struct EPle { float* X; const float* G; __device__ void operator()(int r, int c, float v) const { X[(size_t)r * D + c] += sigmoidf_(G[(size_t)r * D + c]) * v; } };
}

extern "C" void kernel_launch(void* const* d_in, const int* in_sizes, int n_in, void* d_out, int out_size, void* d_ws, size_t ws_size, hipStream_t stream) {
    using namespace nv;
    if (n_in != 29 || out_size != M * D) { fprintf(stderr, "kernel_launch: unexpected shapes\n"); return; }
    const float* x = (const float*)d_in[0]; const float* p = (const float*)d_in[1]; const int* positions = (const int*)d_in[2];
    const float* ln_mix_g = (const float*)d_in[3]; const float* w_in = (const float*)d_in[4]; const float* conv_a_w = (const float*)d_in[5];
    const float* w_out_a = (const float*)d_in[6]; const float* q_norm_g = (const float*)d_in[7]; const float* w_uq = (const float*)d_in[8];
    const float* kv_norm_g = (const float*)d_in[9]; const float* w_ukv = (const float*)d_in[10]; const float* w_out_b = (const float*)d_in[11];
    const float* conv_c_w = (const float*)d_in[12]; const float* ln_c_g = (const float*)d_in[13]; const float* ln_c_b = (const float*)d_in[14];
    const float* w_out_c = (const float*)d_in[15]; const float* w_o = (const float*)d_in[16]; const float* ln_ffn_g = (const float*)d_in[17];
    const float* w_rg = (const float*)d_in[18]; const float* b_rg = (const float*)d_in[19]; const float* w_re = (const float*)d_in[20]; const float* b_re = (const float*)d_in[21];
    const float* w_eg = (const float*)d_in[22]; const float* w_eu = (const float*)d_in[23]; const float* w_ed = (const float*)d_in[24];
    const float* ln_ple_g = (const float*)d_in[25]; const float* w_pg = (const float*)d_in[26]; const float* w_ple = (const float*)d_in[27]; const float* final_g = (const float*)d_in[28];
    float* X = (float*)d_out;
    float* ws = (float*)d_ws; size_t off = 0;
    auto take = [&](size_t n) { float* r = ws + off; off += (n + 63) & ~(size_t)63; return r; };
    float* HN = take((size_t)MC * D); float* PROJ = take((size_t)MC * INC); float* AIN = take((size_t)MC * 512); float* CIN = take((size_t)MC * 512);
    float* QLN = take((size_t)MC * 768); float* KVLN = take((size_t)MC * 256); float* Q = take((size_t)MC * 768); float* KV = take((size_t)MC * 1024);
    float* KR = take((size_t)MC * 32); float* AO = take((size_t)MC * 512); float* MG = take((size_t)MC * D);
    int* SEL = (int*)take((size_t)MC * 2); float* WTS = take((size_t)MC * 2);
    if (off * 4 > ws_size) { fprintf(stderr, "kernel_launch: workspace too small\n"); return; }
    (void)hipMemcpyAsync(X, x, (size_t)M * D * 4, hipMemcpyDeviceToDevice, stream);
    for (int L = 0; L < DEPTH; ++L) {
        const float* Win = w_in + (size_t)L * D * INC;
        for (int c0 = 0; c0 < M; c0 += MC) {
            float* Xc = X + (size_t)c0 * D; const int* posc = positions + c0;
            hipLaunchKernelGGL(rmsnorm_rows, dim3(MC), dim3(256), 0, stream, (const float*)Xc, (long long)D, (long long)D, ln_mix_g + L * D, HN, (long long)D);
            launch_gemm(stream, HN, D, Win, INC, MC, INC, D, EStore{PROJ, INC});
            hipLaunchKernelGGL(mixa_prep, dim3(MC), dim3(512), 0, stream, (const float*)PROJ, conv_a_w + L * 3 * 512, AIN);
            hipLaunchKernelGGL(mixc_prep, dim3(MC), dim3(512), 0, stream, (const float*)PROJ, conv_c_w + L * 31 * 512, ln_c_g + L * 512, ln_c_b + L * 512, CIN);
            launch_gemm(stream, AIN, 512, w_out_a + (size_t)L * 512 * D, D, MC, D, 512, EGateSet{MG, D, PROJ + O_GA, INC});
            launch_gemm(stream, CIN, 512, w_out_c + (size_t)L * 512 * D, D, MC, D, 512, EGateAdd{MG, D, PROJ + O_GC, INC});
            hipLaunchKernelGGL(rmsnorm_rows, dim3(MC), dim3(256), 0, stream, (const float*)(PROJ + O_QL), (long long)INC, 768LL, q_norm_g + L * 768, QLN, 768LL);
            hipLaunchKernelGGL(rmsnorm_rows, dim3(MC), dim3(256), 0, stream, (const float*)(PROJ + O_KVL), (long long)INC, 256LL, kv_norm_g + L * 256, KVLN, 256LL);
            launch_gemm(stream, QLN, 768, w_uq + (size_t)L * 768 * 768, 768, MC, 768, 768, EStore{Q, 768});
            launch_gemm(stream, KVLN, 256, w_ukv + (size_t)L * 256 * 1024, 1024, MC, 1024, 256, EStore{KV, 1024});
            hipLaunchKernelGGL(rope_q, dim3(MC * 8 * 16 / 256), dim3(256), 0, stream, Q, posc);
            hipLaunchKernelGGL(rope_k, dim3(MC * 16 / 256), dim3(256), 0, stream, (const float*)PROJ, KR, posc);
            hipLaunchKernelGGL(attn, dim3(S, 8, MC / S), dim3(64), 0, stream, (const float*)Q, (const float*)KV, (const float*)KR, AO);
            launch_gemm(stream, AO, 512, w_out_b + (size_t)L * 512 * D, D, MC, D, 512, EGateAdd{MG, D, PROJ + O_GB, INC});
            launch_gemm(stream, MG, D, w_o + (size_t)L * D * D, D, MC, D, D, EAdd{Xc, D});
            hipLaunchKernelGGL(rmsnorm_rows, dim3(MC), dim3(256), 0, stream, (const float*)Xc, (long long)D, (long long)D, ln_ffn_g + L * D, HN, (long long)D);
            hipLaunchKernelGGL(route, dim3(MC), dim3(64), 0, stream, (const float*)HN, w_rg + (size_t)L * D * 4, b_rg + L * 4, w_re + (size_t)L * D * 32, b_re + L * 32, SEL, WTS);
            hipLaunchKernelGGL(moe_tok, dim3(MC), dim3(256), 0, stream, (const float*)HN, (const int*)SEL, (const float*)WTS,
                               w_eg + (size_t)L * 32 * D * 256, w_eu + (size_t)L * 32 * D * 256, w_ed + (size_t)L * 32 * 256 * D, Xc);
            hipLaunchKernelGGL(rmsnorm_rows, dim3(MC), dim3(256), 0, stream, (const float*)Xc, (long long)D, (long long)D, ln_ple_g + L * D, HN, (long long)D);
            launch_gemm(stream, HN, D, w_pg + (size_t)L * D * D, D, MC, D, D, EStore{MG, D});
            launch_gemm(stream, p + ((size_t)L * M + c0) * 256, 256, w_ple + (size_t)L * 256 * D, D, MC, D, 256, EPle{Xc, MG});
        }
    }
    for (int c0 = 0; c0 < M; c0 += MC) {
        float* Xc = X + (size_t)c0 * D;
        hipLaunchKernelGGL(rmsnorm_rows, dim3(MC), dim3(256), 0, stream, (const float*)Xc, (long long)D, (long long)D, final_g, Xc, (long long)D);
    }
}
```

```cpp
#include <hip/hip_runtime.h>
#include <cstdio>
#include <cstdint>
#include <cmath>
#define MK_CUT 0
constexpr int NB = 8, S = 2048, M = NB * S, D = 1024, DEPTH = 2, NHEAD = 8;
constexpr int INC = 6688, INC_PAD = 6912;
constexpr float EPS = 1e-6f;
constexpr int NWAVES = 8;
constexpr int MOE_ROWS = 2 * M + 32 * 256;
constexpr int MOE_TILES = MOE_ROWS / 256;

#define GAS __attribute__((address_space(1)))
#define LAS __attribute__((address_space(3)))
typedef unsigned short bf16;
typedef unsigned v4u __attribute__((ext_vector_type(4)));
typedef unsigned v2u __attribute__((ext_vector_type(2)));
typedef float f32x4 __attribute__((ext_vector_type(4)));
typedef float f32x2 __attribute__((ext_vector_type(2)));
typedef GAS unsigned gu32;
#define RLX_AGENT __ATOMIC_RELAXED, __HIP_MEMORY_SCOPE_AGENT

constexpr size_t MiB = 1u << 20;
constexpr size_t WS_CTL = 0, CTL_ZERO_BYTES = 2 * MiB;
constexpr size_t WO_IN = 0;
constexpr size_t WO_OUTA = WO_IN + (size_t)INC_PAD * 1024 * 2;
constexpr size_t WO_OUTC = WO_OUTA + 1024 * 512 * 2;
constexpr size_t WO_OUTB = WO_OUTC + 1024 * 512 * 2;
constexpr size_t WO_UQ = WO_OUTB + 1024 * 512 * 2;
constexpr size_t WO_UKV = WO_UQ + 768 * 768 * 2;
constexpr size_t WO_O = WO_UKV + 1024 * 256 * 2;
constexpr size_t WO_GU = WO_O + 1024 * 1024 * 2;
constexpr size_t WO_DN = WO_GU + (size_t)32 * 512 * 1024 * 2;
constexpr size_t WO_PG = WO_DN + (size_t)32 * 1024 * 256 * 2;
constexpr size_t WO_PLE = WO_PG + 1024 * 1024 * 2;
constexpr size_t WO_WR = WO_PLE + 1024 * 256 * 2;
constexpr size_t WO_END = WO_WR + 36 * 1024 * 4;
constexpr size_t WS_W = 2 * MiB, WS_W_BYTES = 72 * MiB;
static_assert(WO_END <= WS_W_BYTES, "weight region");
constexpr size_t WS_SMALL = WS_W + WS_W_BYTES;
constexpr size_t SM_COSSIN = 0;
constexpr size_t SM_RSTDQ = 2 * MiB, SM_RSTDKV = SM_RSTDQ + M * 4;
constexpr size_t SM_SELE = SM_RSTDKV + M * 4;
constexpr size_t SM_SELR = SM_SELE + M * 8;
constexpr size_t SM_WT = SM_SELR + M * 8;
constexpr size_t SM_TOKPOS = SM_WT + M * 8;
constexpr size_t SM_BASE = SM_TOKPOS + M * 8;
constexpr size_t SM_ROWW = SM_BASE + 256 * 32 * 4;
constexpr size_t SM_END = SM_ROWW + (size_t)MOE_ROWS * 4;
static_assert(SM_END <= 4 * MiB, "small region");
constexpr size_t WS_XN = WS_SMALL + 4 * MiB;
constexpr size_t WS_P16 = WS_XN + 32 * MiB;
constexpr size_t WS_R = WS_P16 + 8 * MiB;
constexpr size_t R_SG = 0;
constexpr size_t R_SCB = R_SG + 96 * MiB;
constexpr size_t R_CU = R_SCB + 16 * MiB;
constexpr size_t R_U = R_CU + 16 * MiB;
constexpr size_t R_QL = R_U + 16 * MiB;
constexpr size_t R_KVL = R_QL + 24 * MiB;
constexpr size_t R_KRR = R_KVL + 8 * MiB;
constexpr size_t R_KROPE = R_KRR + 1 * MiB;
constexpr size_t R_AIN = R_KROPE + 1 * MiB;
constexpr size_t R_CIN = R_AIN + 16 * MiB;
constexpr size_t R_MIX_END = R_CIN + 16 * MiB;
constexpr size_t R_XG = 0;
constexpr size_t R_H = R_XG + (size_t)MOE_ROWS * 1024 * 2;
constexpr size_t R_Y = R_H + (size_t)MOE_ROWS * 256 * 2;
constexpr size_t R_MOE_END = R_Y + (size_t)MOE_ROWS * 1024 * 2;
constexpr size_t R_BYTES = R_MIX_END > R_MOE_END ? R_MIX_END : R_MOE_END;
constexpr size_t WS_END = WS_R + R_BYTES;
constexpr int CW_BAR = 4096;
constexpr int CW_CNT = 1024;
constexpr int RING_BYTES = 131072;
constexpr int LDSCTL_OFF = RING_BYTES, MISC_OFF = LDSCTL_OFF + 320;
constexpr int LT_HIST = LDSCTL_OFF + 1024;
constexpr int LT_BASE = LT_HIST + 128;
constexpr int LT_OFF = LT_BASE + 128;
constexpr int LT_TILE = LT_OFF + 160;
constexpr int LT_NT = LT_TILE + 640;
constexpr int LDS_BYTES = 147456;
static_assert(LT_NT + 16 <= LDS_BYTES, "LDS map");

namespace pg8 {
#define PG8_LAS __attribute__((address_space(3)))
typedef unsigned short bf16_t;
typedef short bf16x8 __attribute__((ext_vector_type(8)));
typedef float f32x4 __attribute__((ext_vector_type(4)));
typedef float f32x2 __attribute__((ext_vector_type(2)));
typedef unsigned u32x4 __attribute__((ext_vector_type(4)));
typedef unsigned u32x2 __attribute__((ext_vector_type(2)));
constexpr int BM = 256, BK = 64, HALF = 128, HTB = HALF * BK * 2  , STAGE_BYTES = 8 * HTB, NXCD = 8, WGM = 8;

__host__ __device__ __forceinline__ int lds_byte(int r, int c) { const int st = (r >> 4) * 2 + (c >> 5), rr = r & 15, cc = c & 31, ob = rr * 64 + cc * 2; return st * 1024 + (ob ^ (((ob >> 9) & 1) << 5)); }
__host__ __device__ __forceinline__ void stage_rc(int b, int& R, int& C) { const int st = b / 1024, sb = b % 1024, swz = sb ^ (((sb >> 9) & 1) << 5); R = (st >> 1) * 16 + swz / 64; C = (st & 1) * 32 + (swz % 64) / 2; }
__host__ __device__ __forceinline__ int perm32(int rho) { const int n = rho >> 4, i = rho & 15; return 8 * (i >> 2) + 4 * n + (i & 3); }

struct Unit { int pm, pn; };
struct Gemm { const bf16_t* A; const bf16_t* Bt; int lda, ldb, K; };

struct StaticOrder {
    int nM, nN, nwg, G, c;
    __device__ void init(int M, int N, int G_, int c_) { nM = M / BM; nN = N / BM; nwg = nM * nN; G = G_; c = c_; }
    __device__ bool next(int i, Unit& u) const {
        const long L = (long)i * G + c; if (L >= nwg) return false;
        int wgid = (int)L; { const int q = nwg / NXCD, r = nwg % NXCD, xcd = wgid % NXCD, off = wgid / NXCD; wgid = (xcd < r ? xcd * (q + 1) : r * (q + 1) + (xcd - r) * q) + off; }
        const int nig = WGM * nN, gid = wgid / nig, fm = gid * WGM, gsz = (nM - fm) < WGM ? (nM - fm) : WGM;
        u.pm = fm + ((wgid % nig) % gsz); u.pn = (wgid % nig) / gsz; return true;
    }
};
struct MoeOrder {
    const PG8_LAS int* tile_e; int nunits, ncol, G, c;
    __device__ bool next(int i, Unit& u) const {
        const int L = i * G + c; if (L >= nunits) return false;
        const int rt = L / ncol, ct = L - rt * ncol; u.pm = rt; u.pn = tile_e[rt] * ncol + ct; return true;
    }
};

typedef __bf16 bf16x2_t __attribute__((ext_vector_type(2)));
__device__ __forceinline__ unsigned cvt_pk_bf16(float lo, float hi) { const f32x2 v = {lo, hi}; const bf16x2_t b = __builtin_convertvector(v, bf16x2_t); return __builtin_bit_cast(unsigned, b); }
__device__ __forceinline__ float bf_lo(unsigned w) { return __uint_as_float(w << 16); }
__device__ __forceinline__ float bf_hi(unsigned w) { return __uint_as_float(w & 0xffff0000u); }
__device__ __forceinline__ float fsigmoid(float x) { return __builtin_amdgcn_rcpf(1.0f + __builtin_amdgcn_exp2f(-1.44269504089f * x)); }
__device__ __forceinline__ u32x4 pack8(const f32x4& a, const f32x4& b) { u32x4 w; w.x = cvt_pk_bf16(a[0], a[1]); w.y = cvt_pk_bf16(a[2], a[3]); w.z = cvt_pk_bf16(b[0], b[1]); w.w = cvt_pk_bf16(b[2], b[3]); return w; }
__device__ __forceinline__ void unpack8(const u32x4& w, f32x4& a, f32x4& b) { a = (f32x4){bf_lo(w.x), bf_hi(w.x), bf_lo(w.y), bf_hi(w.y)}; b = (f32x4){bf_lo(w.z), bf_hi(w.z), bf_lo(w.w), bf_hi(w.w)}; }

#define PG8_FOR_AI_M _Pragma("unroll") for (int ai = 0; ai < 2; ++ai) _Pragma("unroll") for (int m = 0; m < 4; ++m)

struct EpiInProj {
    static constexpr bool PERM = true;
    unsigned char* R;
    __device__ __forceinline__ void operator()(const f32x4 (&acc)[2][2][4][2], const Unit& u, int wr, int wc, int fr, int fq) const {
        const int row0 = u.pm * BM + wr * 64 + fr, pn = u.pn, cl = wc * 32 + 8 * fq;
        bf16_t* SG = (bf16_t*)(R + R_SG); bf16_t* SCB = (bf16_t*)(R + R_SCB); bf16_t* CU = (bf16_t*)(R + R_CU); bf16_t* QL = (bf16_t*)(R + R_QL);
        bf16_t* KVL = (bf16_t*)(R + R_KVL); bf16_t* U = (bf16_t*)(R + R_U); bf16_t* KRR = (bf16_t*)(R + R_KRR);
        if (pn < 12) {
            PG8_FOR_AI_M { bf16_t* rp = SG + (size_t)(row0 + ai * HALF + m * 16) * 3072 + pn * 256 + cl;
#pragma unroll
                for (int bj = 0; bj < 2; ++bj) { f32x4 a = acc[ai][bj][m][0], b = acc[ai][bj][m][1];
#pragma unroll
                    for (int j = 0; j < 4; ++j) { a[j] = fsigmoid(a[j]); b[j] = fsigmoid(b[j]); }
                    *(u32x4*)(rp + bj * HALF) = pack8(a, b); } }
        } else if (pn < 14) {
            PG8_FOR_AI_M { bf16_t* rp = SCB + (size_t)(row0 + ai * HALF + m * 16) * 512 + (pn - 12) * 256 + cl;
#pragma unroll
                for (int bj = 0; bj < 2; ++bj) *(u32x4*)(rp + bj * HALF) = pack8(acc[ai][bj][m][0], acc[ai][bj][m][1]); }
        } else if (pn < 18) {
            PG8_FOR_AI_M { bf16_t* rp = CU + (size_t)(row0 + ai * HALF + m * 16) * 512 + (pn - 14) * 128 + cl;
                *(u32x4*)rp = pack8(acc[ai][0][m][0] * acc[ai][1][m][0], acc[ai][0][m][1] * acc[ai][1][m][1]); }
        } else if (pn < 21) {
            PG8_FOR_AI_M { bf16_t* rp = QL + (size_t)(row0 + ai * HALF + m * 16) * 768 + (pn - 18) * 256 + cl;
#pragma unroll
                for (int bj = 0; bj < 2; ++bj) *(u32x4*)(rp + bj * HALF) = pack8(acc[ai][bj][m][0], acc[ai][bj][m][1]); }
        } else if (pn == 21) {
            PG8_FOR_AI_M { bf16_t* rp = KVL + (size_t)(row0 + ai * HALF + m * 16) * 256 + cl;
#pragma unroll
                for (int bj = 0; bj < 2; ++bj) *(u32x4*)(rp + bj * HALF) = pack8(acc[ai][bj][m][0], acc[ai][bj][m][1]); }
        } else if (pn < 26) {
            PG8_FOR_AI_M { bf16_t* rp = U + (size_t)(row0 + ai * HALF + m * 16) * 512 + (pn - 22) * 128 + cl;
                f32x4 a = acc[ai][0][m][0], b = acc[ai][0][m][1]; const f32x4 ga = acc[ai][1][m][0], gb = acc[ai][1][m][1];
#pragma unroll
                for (int j = 0; j < 4; ++j) { a[j] *= fsigmoid(ga[j]); b[j] *= fsigmoid(gb[j]); }
                *(u32x4*)rp = pack8(a, b); }
        } else {
            if (wc == 0) { PG8_FOR_AI_M { bf16_t* rp = KRR + (size_t)(row0 + ai * HALF + m * 16) * 32 + cl; *(u32x4*)rp = pack8(acc[ai][0][m][0], acc[ai][0][m][1]); } }
        }
    }
};
template <bool FIRST> struct EpiGateRmw {
    static constexpr bool PERM = true;
    bf16_t* SG; int gcol;
    __device__ __forceinline__ void operator()(const f32x4 (&acc)[2][2][4][2], const Unit& u, int wr, int wc, int fr, int fq) const {
        const int row0 = u.pm * BM + wr * 64 + fr, cl = wc * 32 + 8 * fq;
        PG8_FOR_AI_M { bf16_t* rp = SG + (size_t)(row0 + ai * HALF + m * 16) * 3072 + u.pn * 256 + cl;
#pragma unroll
            for (int bj = 0; bj < 2; ++bj) { const u32x4 gw = *(const u32x4*)(rp + gcol + bj * HALF); f32x4 g0, g1; unpack8(gw, g0, g1);
                f32x4 o0 = g0 * acc[ai][bj][m][0], o1 = g1 * acc[ai][bj][m][1];
                if (!FIRST) { const u32x4 mw = *(const u32x4*)(rp + bj * HALF); f32x4 m0, m1; unpack8(mw, m0, m1); o0 += m0; o1 += m1; }
                *(u32x4*)(rp + bj * HALF) = pack8(o0, o1); }
            if (m & 1) asm volatile("" ::: "memory"); }
    }
};
struct EpiQ {
    static constexpr bool PERM = false;
    unsigned char* ws;
    __device__ __forceinline__ void operator()(const f32x4 (&acc)[2][2][4][2], const Unit& u, int wr, int wc, int fr, int fq) const {
        const int row0 = u.pm * BM + wr * 64 + fr;
        bf16_t* Q = (bf16_t*)(ws + WS_XN); const float* rstd = (const float*)(ws + WS_SMALL + SM_RSTDQ); const f32x2* cossin = (const f32x2*)(ws + WS_SMALL + SM_COSSIN);
        constexpr float C2 = 0.10206207261596575f * 1.4426950408889634f;
        PG8_FOR_AI_M { const int row = row0 + ai * HALF + m * 16; const float rs = rstd[row] * C2;
#pragma unroll
            for (int bj = 0; bj < 2; ++bj) { const int g32 = 8 * u.pn + 4 * bj + wc; bf16_t* rp = Q + (size_t)row * 768 + 32 * g32 + 4 * fq;
                f32x4 a = acc[ai][bj][m][0] * rs, b = acc[ai][bj][m][1] * rs;
                if (g32 % 3 == 2) { const f32x2* cs = cossin + (size_t)row * 16 + 4 * fq; f32x4 o1, o2;
#pragma unroll
                    for (int j = 0; j < 4; ++j) { const f32x2 c = cs[j]; o1[j] = a[j] * c.x - b[j] * c.y; o2[j] = a[j] * c.y + b[j] * c.x; }
                    a = o1; b = o2; }
                u32x2 w0, w1; w0.x = cvt_pk_bf16(a[0], a[1]); w0.y = cvt_pk_bf16(a[2], a[3]); w1.x = cvt_pk_bf16(b[0], b[1]); w1.y = cvt_pk_bf16(b[2], b[3]);
                *(u32x2*)rp = w0; *(u32x2*)(rp + 16) = w1; }
            if (m & 1) asm volatile("" ::: "memory"); }
    }
};
struct EpiKV {
    static constexpr bool PERM = true;
    unsigned char* ws;
    __device__ __forceinline__ void operator()(const f32x4 (&acc)[2][2][4][2], const Unit& u, int wr, int wc, int fr, int fq) const {
        const int row0 = u.pm * BM + wr * 64 + fr;
        const float* rstd = (const float*)(ws + WS_SMALL + SM_RSTDKV);
        bf16_t* dst = (bf16_t*)(ws + WS_R + ((wc < 2) ? R_SCB : R_CU)); const int cw = (wc & 1) * 32 + 8 * fq;
        PG8_FOR_AI_M { const int row = row0 + ai * HALF + m * 16; const float rs = rstd[row];
#pragma unroll
            for (int bj = 0; bj < 2; ++bj) *(u32x4*)(dst + (size_t)row * 512 + (2 * u.pn + bj) * 64 + cw) = pack8(acc[ai][bj][m][0] * rs, acc[ai][bj][m][1] * rs); }
    }
};
struct EpiResF32 {
    static constexpr bool PERM = false;
    const float* Xin; float* Xout;
    __device__ __forceinline__ void operator()(const f32x4 (&acc)[2][2][4][2], const Unit& u, int wr, int wc, int fr, int fq) const {
        const int row0 = u.pm * BM + wr * 64 + fr, c0 = u.pn * BM + wc * 32 + 4 * fq;
        PG8_FOR_AI_M { const size_t off = (size_t)(row0 + ai * HALF + m * 16) * 1024 + c0;
#pragma unroll
            for (int bj = 0; bj < 2; ++bj)
#pragma unroll
                for (int n = 0; n < 2; ++n) { const f32x4 x = *(const f32x4*)(Xin + off + bj * HALF + n * 16); *(f32x4*)(Xout + off + bj * HALF + n * 16) = x + acc[ai][bj][m][n]; }
            if (m & 1) asm volatile("" ::: "memory"); }
    }
};
struct EpiMoeGU {
    static constexpr bool PERM = true;
    unsigned char* ws;
    __device__ __forceinline__ void operator()(const f32x4 (&acc)[2][2][4][2], const Unit& u, int wr, int wc, int fr, int fq) const {
        const int row0 = u.pm * BM + wr * 64 + fr, cl = (u.pn & 1) * 128 + wc * 32 + 8 * fq;
        bf16_t* H = (bf16_t*)(ws + WS_R + R_H); const float* roww = (const float*)(ws + WS_SMALL + SM_ROWW);
        PG8_FOR_AI_M { const int row = row0 + ai * HALF + m * 16; const float rw = roww[row];
            f32x4 a = acc[ai][0][m][0], b = acc[ai][0][m][1]; const f32x4 ua = acc[ai][1][m][0], ub = acc[ai][1][m][1];
#pragma unroll
            for (int j = 0; j < 4; ++j) { a[j] = a[j] * fsigmoid(a[j]) * ua[j] * rw; b[j] = b[j] * fsigmoid(b[j]) * ub[j] * rw; }
            *(u32x4*)(H + (size_t)row * 256 + cl) = pack8(a, b); }
    }
};
struct EpiStoreBf16 {
    static constexpr bool PERM = true;
    bf16_t* O; int ldc, cmask;
    __device__ __forceinline__ void operator()(const f32x4 (&acc)[2][2][4][2], const Unit& u, int wr, int wc, int fr, int fq) const {
        const int row0 = u.pm * BM + wr * 64 + fr, cl = (u.pn & cmask) * 256 + wc * 32 + 8 * fq;
        PG8_FOR_AI_M { bf16_t* rp = O + (size_t)(row0 + ai * HALF + m * 16) * ldc + cl;
#pragma unroll
            for (int bj = 0; bj < 2; ++bj) *(u32x4*)(rp + bj * HALF) = pack8(acc[ai][bj][m][0], acc[ai][bj][m][1]); }
    }
};
struct EpiPle {
    static constexpr bool PERM = false;
    float* X; unsigned char* ws;
    __device__ __forceinline__ void operator()(const f32x4 (&acc)[2][2][4][2], const Unit& u, int wr, int wc, int fr, int fq) const {
        const int row0 = u.pm * BM + wr * 64 + fr, c0 = u.pn * BM + wc * 32 + 4 * fq;
        const bf16_t* PE = (const bf16_t*)(ws + WS_R + R_XG);
        PG8_FOR_AI_M { const size_t off = (size_t)(row0 + ai * HALF + m * 16) * 1024 + c0;
#pragma unroll
            for (int bj = 0; bj < 2; ++bj)
#pragma unroll
                for (int n = 0; n < 2; ++n) { const size_t o = off + bj * HALF + n * 16; const u32x2 pw = *(const u32x2*)(PE + o); const f32x4 x = *(const f32x4*)(X + o); const f32x4 a = acc[ai][bj][m][n];
                    f32x4 r; r[0] = x[0] + fsigmoid(a[0]) * bf_lo(pw.x); r[1] = x[1] + fsigmoid(a[1]) * bf_hi(pw.x); r[2] = x[2] + fsigmoid(a[2]) * bf_lo(pw.y); r[3] = x[3] + fsigmoid(a[3]) * bf_hi(pw.y);
                    *(f32x4*)(X + o) = r; }
            if (m & 1) asm volatile("" ::: "memory"); }
    }
};

template <class Epi, class Sched, bool ALIGN_EPI = true>
__device__ __forceinline__ void gemm_phase(PG8_LAS unsigned char* lds, const Gemm g, const Sched& S, const Epi& E) {
    int tid = threadIdx.x; asm volatile("" : "+v"(tid));
    const int wid = __builtin_amdgcn_readfirstlane(tid >> 6), lane = tid & 63, wr = wid >> 2, wc = wid & 3, fr = lane & 15, fq = lane >> 4;
    const int K = g.K, nt = K / BK;
    unsigned voffA[2], voffB[2];
#pragma unroll
    for (int i = 0; i < 2; ++i) { int R, C; stage_rc(tid * 16 + i * 8192, R, C); const int Rb = Epi::PERM ? ((R & ~31) + perm32(R & 31)) : R;
        voffA[i] = (unsigned)(R * g.lda + C) * 2u; voffB[i] = (unsigned)(Rb * g.ldb + C) * 2u; }
    constexpr unsigned kstep = BK * 2;
    const unsigned hstepA = (unsigned)HALF * g.lda * 2, hstepB = (unsigned)HALF * g.ldb * 2;
    const unsigned tstepA = 2 * hstepA, tstepB = 2 * hstepB;
    const char* const Ab = (const char*)g.A; const char* const Bb = (const char*)g.Bt;
    const unsigned ldsw = (unsigned)wid * 1024u;
    const int aoff = lds_byte(wr * 64 + fr, fq * 8), boff = lds_byte(wc * 32 + fr, fq * 8);
#define PG8_SA(b, h) (((b) * 2 + (h)) * HTB)
#define PG8_SB(b, h) ((4 + (b) * 2 + (h)) * HTB)
#define PG8_STAGE(bufoff, gbase, voff) do { const char* _gb = (const char*)(gbase); asm volatile("" : "+s"(_gb));     \
        _Pragma("unroll") for (int _i = 0; _i < 2; ++_i) \
        __builtin_amdgcn_global_load_lds((const unsigned*)(_gb + (voff)[_i]), (PG8_LAS unsigned*)(lds + (bufoff) + ldsw + _i * 8192), 16, 0, 0); } while (0)
#define PG8_LDA(dst, b, h) do { _Pragma("unroll") for (int m = 0; m < 4; ++m) _Pragma("unroll") for (int k = 0; k < 2; ++k) dst[m][k] = *(const PG8_LAS bf16x8*)(lds + PG8_SA(b, h) + aoff + m * 2048 + k * 1024); } while (0)
#define PG8_LDB(dst, b, h) do { _Pragma("unroll") for (int n = 0; n < 2; ++n) _Pragma("unroll") for (int k = 0; k < 2; ++k) dst[n][k] = *(const PG8_LAS bf16x8*)(lds + PG8_SB(b, h) + boff + n * 2048 + k * 1024); } while (0)
#define PG8_MMA(ai, bj, At, Bt) do { __builtin_amdgcn_s_setprio(1); _Pragma("unroll") for (int m = 0; m < 4; ++m) _Pragma("unroll") for (int n = 0; n < 2; ++n) _Pragma("unroll") for (int k = 0; k < 2; ++k) \
        acc[ai][bj][m][n] = __builtin_amdgcn_mfma_f32_16x16x32_bf16(Bt[n][k], At[m][k], acc[ai][bj][m][n], 0, 0, 0); __builtin_amdgcn_s_setprio(0); } while (0)
#define PG8_WAIT_V(n) asm volatile("s_waitcnt vmcnt(" #n ")" ::: "memory")
#define PG8_WAIT_L(n) asm volatile("s_waitcnt lgkmcnt(" #n ")" ::: "memory")
#define PG8_BAR __builtin_amdgcn_s_barrier()
#define PG8_SCHED __builtin_amdgcn_sched_barrier(0)
    Unit cur, nxt; int ui = 0;
    if (!S.next(0, cur)) return;
    f32x4 acc[2][2][4][2];
#pragma unroll
    for (int a = 0; a < 2; ++a)
#pragma unroll
        for (int b = 0; b < 2; ++b)
#pragma unroll
            for (int m = 0; m < 4; ++m)
#pragma unroll
                for (int n = 0; n < 2; ++n) acc[a][b][m][n] = (f32x4){0.f, 0.f, 0.f, 0.f};
    bf16x8 At[4][2], B0[2][2], B1[2][2];
    unsigned cA = (unsigned)cur.pm * tstepA, cB = (unsigned)cur.pn * tstepB;
    PG8_STAGE(PG8_SB(0, 0), Bb + cB, voffB); PG8_STAGE(PG8_SB(0, 1), Bb + (cB + hstepB), voffB); PG8_STAGE(PG8_SA(0, 0), Ab + cA, voffA); PG8_STAGE(PG8_SA(0, 1), Ab + (cA + hstepA), voffA);
    if (wr == 1) PG8_BAR;
    PG8_WAIT_V(2); PG8_BAR;
    PG8_STAGE(PG8_SB(1, 0), Bb + (cB + kstep), voffB); PG8_STAGE(PG8_SA(1, 0), Ab + (cA + kstep), voffA); PG8_STAGE(PG8_SB(1, 1), Bb + (cB + hstepB + kstep), voffB);
    PG8_WAIT_V(6); PG8_BAR;
    for (;;) {
        const bool has_next = S.next(ui + 1, nxt);
        const unsigned nA = has_next ? (unsigned)nxt.pm * tstepA : cA; const unsigned nB = has_next ? (unsigned)nxt.pn * tstepB : cB;
#pragma unroll 1
        for (int t = 0; t < nt; t += 2) {
            const bool last = (t == nt - 2);
            const char* a1 = Ab + (cA + (unsigned)(t + 1) * kstep);
            const unsigned a2o = last ? nA : cA + (unsigned)(t + 2) * kstep, b2o = last ? nB : cB + (unsigned)(t + 2) * kstep;
            const char* a2 = Ab + a2o; const char* b2 = Bb + b2o;
            const char* a3 = a2 + kstep; const char* b3 = b2 + kstep;
            PG8_LDB(B0, 0, 0); PG8_LDB(B1, 0, 1); PG8_SCHED; PG8_LDA(At, 0, 0); PG8_STAGE(PG8_SA(1, 1), a1 + hstepA, voffA);
            PG8_WAIT_V(8); PG8_WAIT_L(0); PG8_BAR; PG8_MMA(0, 0, At, B0); PG8_MMA(0, 1, At, B1); PG8_BAR; PG8_SCHED;
            PG8_LDA(At, 0, 1); PG8_STAGE(PG8_SB(0, 0), b2, voffB); PG8_STAGE(PG8_SB(0, 1), b2 + hstepB, voffB); PG8_STAGE(PG8_SA(0, 0), a2, voffA);
            PG8_WAIT_V(8); PG8_WAIT_L(0); PG8_BAR; PG8_MMA(1, 0, At, B0); PG8_MMA(1, 1, At, B1); PG8_BAR; PG8_SCHED;
            PG8_LDB(B0, 1, 0); PG8_LDB(B1, 1, 1); PG8_SCHED; PG8_LDA(At, 1, 0); PG8_STAGE(PG8_SA(0, 1), a2 + hstepA, voffA);
            PG8_WAIT_V(8); PG8_WAIT_L(0); PG8_BAR; PG8_MMA(0, 0, At, B0); PG8_MMA(0, 1, At, B1); PG8_BAR; PG8_SCHED;
            PG8_LDA(At, 1, 1); PG8_STAGE(PG8_SB(1, 0), b3, voffB); PG8_STAGE(PG8_SB(1, 1), b3 + hstepB, voffB); PG8_STAGE(PG8_SA(1, 0), a3, voffA);
            PG8_WAIT_V(8); PG8_WAIT_L(0); PG8_BAR; PG8_MMA(1, 0, At, B0); PG8_MMA(1, 1, At, B1); PG8_BAR; PG8_SCHED;
        }
        if constexpr (ALIGN_EPI) { if (wr == 0) PG8_BAR; }
        E(acc, cur, wr, wc, fr, fq);
        if (!has_next) break;
#pragma unroll
        for (int a = 0; a < 2; ++a)
#pragma unroll
            for (int b = 0; b < 2; ++b)
#pragma unroll
                for (int m = 0; m < 4; ++m)
#pragma unroll
                    for (int n = 0; n < 2; ++n) acc[a][b][m][n] = (f32x4){0.f, 0.f, 0.f, 0.f};
        cur = nxt; cA = nA; cB = nB; ++ui;
        if constexpr (ALIGN_EPI) { if (wr == 1) PG8_BAR; }
    }
    PG8_WAIT_V(0);
    if constexpr (!ALIGN_EPI) { if (wr == 0) PG8_BAR; }
    PG8_BAR;
#undef PG8_SA
#undef PG8_SB
#undef PG8_STAGE
#undef PG8_LDA
#undef PG8_LDB
#undef PG8_MMA
#undef PG8_WAIT_V
#undef PG8_WAIT_L
#undef PG8_BAR
#undef PG8_SCHED
}
}
using pg8::cvt_pk_bf16; using pg8::bf_lo; using pg8::bf_hi; using pg8::fsigmoid;
namespace attn {
using bf16x8 = __attribute__((ext_vector_type(8))) short;
using s16x4 = __attribute__((ext_vector_type(4))) short;
using f32x16 = __attribute__((ext_vector_type(16))) float;
using u32x4 = __attribute__((ext_vector_type(4))) unsigned;
typedef LAS char* lptr;
typedef const LAS char* lcptr;
constexpr int KSLOT = 12288, VSLOT = 8192;
constexpr int LDS_K = 0, LDS_V = 2 * KSLOT, LDS_WS = LDS_V + 2 * VSLOT, LDS_OST = LDS_WS + 8 * 256, LDS_BYTES = LDS_OST + 8 * 4096;
__device__ __forceinline__ int crow(int r, int hi) { return (r & 3) + 8 * (r >> 2) + 4 * hi; }
__device__ __forceinline__ void glds16(const void* gsrc, unsigned lds_dst) { unsigned keep;
    asm volatile("s_mov_b32 %0, m0\n\ts_mov_b32 m0, %2\n\ts_nop 0\n\tglobal_load_lds_dwordx4 %1, off\n\ts_mov_b32 m0, %0" : "=&s"(keep) : "v"(gsrc), "s"(lds_dst) : "memory"); }
__device__ __forceinline__ unsigned cvtpk_s(float lo, float hi) { return cvt_pk_bf16(lo, hi); }
__device__ __forceinline__ void cmask(f32x16& p0, f32x16& p1, int jb, int qrel, int hi) {
    const float NEG = -INFINITY; const int kb = 64 * jb + 4 * hi;
#pragma unroll
    for (int r = 0; r < 16; ++r) { const int kv = kb + (r & 3) + 8 * (r >> 2); if (kv > qrel) p0[r] = NEG; if (kv + 32 > qrel) p1[r] = NEG; }
}
__device__ __forceinline__ void qkt6(f32x16& p0, f32x16& p1, lcptr kb, const bf16x8* qr) {
    f32x16 z = {};
#pragma unroll
    for (int d0 = 0; d0 < 6; ++d0) {
        const bf16x8 b0 = *(const LAS bf16x8*)(kb + d0 * 2048);
        const bf16x8 b1 = *(const LAS bf16x8*)(kb + d0 * 2048 + 512);
        if (d0 == 0) { p0 = __builtin_amdgcn_mfma_f32_32x32x16_bf16(b0, qr[0], z, 0, 0, 0); p1 = __builtin_amdgcn_mfma_f32_32x32x16_bf16(b1, qr[0], z, 0, 0, 0); }
        else { p0 = __builtin_amdgcn_mfma_f32_32x32x16_bf16(b0, qr[d0], p0, 0, 0, 0); p1 = __builtin_amdgcn_mfma_f32_32x32x16_bf16(b1, qr[d0], p1, 0, 0, 0); }
    }
}
__device__ __forceinline__ float rowmax(const f32x16& p0, const f32x16& p1) {
    float a = fmaxf(p0[0], p1[0]);
#pragma unroll
    for (int r = 1; r < 16; ++r) a = fmaxf(a, fmaxf(p0[r], p1[r]));
    auto rr = __builtin_amdgcn_permlane32_swap(__float_as_uint(a), __float_as_uint(a), false, false);
    return fmaxf(__uint_as_float(rr[0]), __uint_as_float(rr[1]));
}
__device__ __forceinline__ void pv(f32x16* o, int vb, bf16x8 pa0, bf16x8 pa1, bf16x8 pa2, bf16x8 pa3) {
#pragma unroll
    for (int d0 = 0; d0 < 2; ++d0) { s16x4 lo[4], hi[4];
#pragma unroll
        for (int ks = 0; ks < 4; ++ks) {
            asm volatile("ds_read_b64_tr_b16 %0,%1 offset:%c2" : "=&v"(lo[ks]) : "v"(vb), "i"(d0 * 4096 + ks * 1024) : "memory");
            asm volatile("ds_read_b64_tr_b16 %0,%1 offset:%c2" : "=&v"(hi[ks]) : "v"(vb), "i"(d0 * 4096 + ks * 1024 + 512) : "memory"); }
        asm volatile("s_waitcnt lgkmcnt(0)" ::: "memory"); __builtin_amdgcn_sched_barrier(0);
#define ATT_PK(k) (bf16x8){lo[k][0], lo[k][1], lo[k][2], lo[k][3], hi[k][0], hi[k][1], hi[k][2], hi[k][3]}
        o[d0] = __builtin_amdgcn_mfma_f32_32x32x16_bf16(pa0, ATT_PK(0), o[d0], 0, 0, 0);
        o[d0] = __builtin_amdgcn_mfma_f32_32x32x16_bf16(pa1, ATT_PK(1), o[d0], 0, 0, 0);
        o[d0] = __builtin_amdgcn_mfma_f32_32x32x16_bf16(pa2, ATT_PK(2), o[d0], 0, 0, 0);
        o[d0] = __builtin_amdgcn_mfma_f32_32x32x16_bf16(pa3, ATT_PK(3), o[d0], 0, 0, 0);
#undef ATT_PK
    }
}
__device__ __forceinline__ void attn_unit(int b, int h, int qb, const bf16* Q, const bf16* Kn, const bf16* Kr, const bf16* V, bf16* O, lptr shm) {
    int tid = threadIdx.x; asm volatile("" : "+v"(tid));
    const int lane = tid & 63, r32 = lane & 31, hi = lane >> 5; const int wid = __builtin_amdgcn_readfirstlane(tid >> 6);
    const long rowbase = (long)b * S; const int q0 = qb * 256;
    const bf16* Qw = Q + (rowbase + q0 + wid * 32) * 768 + h * 96;
    const unsigned lds0 = (unsigned)(size_t)shm;
    LAS float* wsf = (LAS float*)(shm + LDS_WS) + wid * 64;
    const bf16* ksrc = Kn + (rowbase + lane) * 512 + h * 64 + wid * 8;
    const bf16* krsrc = Kr + (rowbase + lane) * 32 + (wid & 3) * 8;
    const bf16* vsrc = V + (rowbase + 16 * (wid & 3) + (lane >> 2)) * 512 + h * 64 + (wid >> 2) * 32 + (lane & 3) * 8;
    const unsigned kdst = lds0 + LDS_K + wid * 1024, krdst = lds0 + LDS_K + (8 + (wid & 3)) * 1024, vdst = lds0 + LDS_V + wid * 1024;
#define ATT_DMA_K(t, so) do { glds16(ksrc + (long)(t) * 64 * 512, (unsigned)__builtin_amdgcn_readfirstlane(kdst + (so))); \
        if (wid < 4) glds16(krsrc + (long)(t) * 64 * 32, (unsigned)__builtin_amdgcn_readfirstlane(krdst + (so))); } while (0)
#define ATT_DMA_V(t, so) glds16(vsrc + (long)(t) * 64 * 512, (unsigned)__builtin_amdgcn_readfirstlane(vdst + (so)))
    const int vb0 = (int)(lds0 + LDS_V) + ((lane >> 4) & 1) * 32 + (lane & 3) * 8 + (4 * hi + ((lane & 15) >> 2)) * 64;
    const lcptr kp0 = (lcptr)shm + LDS_K + hi * 1024 + r32 * 16;
    const int NT = (q0 + 256) / 64;
    ATT_DMA_K(0, 0); ATT_DMA_V(0, 0);
    bf16x8 qr[6];
#pragma unroll
    for (int d0 = 0; d0 < 6; ++d0) qr[d0] = *reinterpret_cast<const bf16x8*>(&Qw[(long)r32 * 768 + d0 * 16 + hi * 8]);
    float m_run = -1e30f, l_run = 0.f; f32x16 o[2]; o[0] = f32x16{}; o[1] = f32x16{};
    const int qrel = wid * 32 + r32;
    asm volatile("s_waitcnt vmcnt(0) lgkmcnt(0)\n\ts_barrier" ::: "memory");
    for (int t = 0; t < NT; ++t) {
        const int cur = t & 1;
        if (t + 1 < NT) { ATT_DMA_K(t + 1, (cur ^ 1) * KSLOT); ATT_DMA_V(t + 1, (cur ^ 1) * VSLOT); }
        f32x16 p0, p1;
        qkt6(p0, p1, kp0 + cur * KSLOT, qr);
        const int jb = t - (NT - 4);
        if (jb >= 0) cmask(p0, p1, jb, qrel, hi);
        const float rm = rowmax(p0, p1);
        const float m_new = fmaxf(m_run, rm);
        const float alpha = __builtin_amdgcn_exp2f(m_run - m_new);
        m_run = m_new;
        float sacc = 0.f;
#pragma unroll
        for (int r = 0; r < 16; ++r) { p0[r] = __builtin_amdgcn_exp2f(p0[r] - m_new); p1[r] = __builtin_amdgcn_exp2f(p1[r] - m_new); sacc += p0[r] + p1[r]; }
        l_run = l_run * alpha + sacc;
        if (__any(alpha != 1.0f)) {
            if (hi == 0) wsf[r32] = alpha;
            asm volatile("s_waitcnt lgkmcnt(0)" ::: "memory");
#pragma unroll
            for (int r = 0; r < 16; ++r) { const float f = wsf[crow(r, hi)]; o[0][r] *= f; o[1][r] *= f; }
        }
        u32x4 pw0, pw1, pw2, pw3;
#define ATT_PKW(P, B) cvtpk_s(P[B], P[B + 1])
        pw0 = (u32x4){ATT_PKW(p0, 0), ATT_PKW(p0, 2), ATT_PKW(p0, 4), ATT_PKW(p0, 6)}; pw1 = (u32x4){ATT_PKW(p0, 8), ATT_PKW(p0, 10), ATT_PKW(p0, 12), ATT_PKW(p0, 14)};
        pw2 = (u32x4){ATT_PKW(p1, 0), ATT_PKW(p1, 2), ATT_PKW(p1, 4), ATT_PKW(p1, 6)}; pw3 = (u32x4){ATT_PKW(p1, 8), ATT_PKW(p1, 10), ATT_PKW(p1, 12), ATT_PKW(p1, 14)};
#undef ATT_PKW
        pv(o, vb0 + cur * VSLOT, __builtin_bit_cast(bf16x8, pw0), __builtin_bit_cast(bf16x8, pw1), __builtin_bit_cast(bf16x8, pw2), __builtin_bit_cast(bf16x8, pw3));
        asm volatile("s_waitcnt vmcnt(0) lgkmcnt(0)\n\ts_barrier" ::: "memory");
    }
    { auto rr = __builtin_amdgcn_permlane32_swap(__float_as_uint(l_run), __float_as_uint(l_run), false, false); l_run = __uint_as_float(rr[0]) + __uint_as_float(rr[1]); }
    if (hi == 0) wsf[32 + r32] = l_run;
    asm volatile("s_waitcnt lgkmcnt(0)" ::: "memory");
    float rli[16];
#pragma unroll
    for (int r = 0; r < 16; ++r) rli[r] = __builtin_amdgcn_rcpf(wsf[32 + crow(r, hi)]);
    bf16* Ow = O + (rowbase + q0 + wid * 32) * 512 + h * 64;
    { LAS bf16* stg = (LAS bf16*)(shm + LDS_OST) + wid * 2048;
#pragma unroll
        for (int r = 0; r < 16; ++r) { const int orow = crow(r, hi);
#pragma unroll
            for (int d0 = 0; d0 < 2; ++d0) stg[orow * 64 + d0 * 32 + r32] = (bf16)(cvt_pk_bf16(o[d0][r] * rli[r], 0.f) & 0xffffu); }
        asm volatile("s_waitcnt lgkmcnt(0)" ::: "memory");
#pragma unroll
        for (int i = 0; i < 4; ++i) { const int row = i * 8 + (lane >> 3), ch = lane & 7; const u32x4 v = *(const LAS u32x4*)(stg + row * 64 + ch * 8); *(u32x4*)(Ow + (long)row * 512 + ch * 8) = v; } }
    asm volatile("s_waitcnt lgkmcnt(0)\n\ts_barrier" ::: "memory");
#undef ATT_DMA_K
#undef ATT_DMA_V
}
}

static_assert(attn::LDS_BYTES <= RING_BYTES, "attention LDS");
#define LDS_WAIT() asm volatile("s_waitcnt lgkmcnt(0)" ::: "memory")
#define VM_WAIT() asm volatile("s_waitcnt vmcnt(0)" ::: "memory")

#define XB_TMO      128
#define XB_XCNT(j)  (256  + 64 * (j))
#define XB_XSUB(j)  (1280 + 64 * (j))
#define XB_XGEN(j)  (2304 + 64 * (j))
#define XB_TOP      3328
#define XB_TOPGEN   3392
#define XCD_BAR_WORDS 3456
#define XB_SPIN_CAP (1u << 18)
__device__ __forceinline__ unsigned xb_ld(unsigned* p)              { return __hip_atomic_load(p, __ATOMIC_RELAXED, __HIP_MEMORY_SCOPE_AGENT); }
__device__ __forceinline__ unsigned xb_add(unsigned* p, unsigned v) { return __hip_atomic_fetch_add(p, v, __ATOMIC_RELAXED, __HIP_MEMORY_SCOPE_AGENT); }
__device__ __forceinline__ unsigned xb_xcc_id() { return (unsigned)__builtin_amdgcn_s_getreg((3 << 11) | 20) & 0xFu; }
#define XB_SPIN(cond, bar) do { unsigned _sp = 0; while (cond) { __builtin_amdgcn_s_sleep(1); \
    if ((++_sp & 255u) == 0u) { if (xb_ld(&(bar)[XB_TMO])) break; if (_sp > XB_SPIN_CAP) { atomicAdd(&(bar)[XB_TMO], 1u); break; } } } } while (0)
struct XcdBarrier { unsigned* bar; unsigned x; volatile LAS unsigned* st; };
__device__ __forceinline__ XcdBarrier xcd_barrier_post(unsigned* bar, volatile LAS unsigned* st) {
    XcdBarrier b; b.bar = bar; b.x = xb_xcc_id(); b.st = st;
    if (threadIdx.x == 0) (void)xb_add(&bar[XB_XCNT(b.x)], 1u);
    return b;
}
__device__ __forceinline__ void xcd_barrier_complete(unsigned* bar, unsigned x, unsigned& nloc, unsigned& nx) {
    const unsigned G = gridDim.x * gridDim.y * gridDim.z;
    unsigned sum, cnt, mine, sp = 0u;
    for (;;) {
        sum = 0u; cnt = 0u; mine = 0u;
#pragma unroll 1
        for (unsigned j = 0; j < 16; ++j) { const unsigned c = xb_ld(&bar[XB_XCNT(j)]); sum += c; cnt += (c > 0u) ? 1u : 0u; mine = (j == x) ? c : mine; }
        if (sum == G) break;
        __builtin_amdgcn_s_sleep(1);
        if ((++sp & 255u) == 0u) { if (xb_ld(&bar[XB_TMO])) break; if (sp > XB_SPIN_CAP) { atomicAdd(&bar[XB_TMO], 1u); break; } }
    }
    nloc = mine > 0u ? mine : 1u; nx = cnt > 0u ? cnt : 1u;
}
__device__ __forceinline__ void xcd_barrier(const XcdBarrier& b) {
    asm volatile("s_waitcnt vmcnt(0)" ::: "memory");
    __syncthreads();
    if (threadIdx.x == 0) {
        unsigned* bar = b.bar;
        __builtin_amdgcn_s_waitcnt(0);
        unsigned nloc = b.st[0], nx = b.st[1];
        const unsigned bx_ = xb_xcc_id();
        if (nloc == 0u) { xcd_barrier_complete(bar, bx_, nloc, nx); b.st[0] = nloc; b.st[1] = nx; }
        const unsigned old = xb_add(&bar[XB_XSUB(bx_)], 1u);
        const unsigned gen = old / nloc;
        if (old + 1u == (gen + 1u) * nloc) {
            __builtin_amdgcn_fence(__ATOMIC_RELEASE, "agent");
            asm volatile("s_waitcnt vmcnt(0)" ::: "memory");
            const unsigned og = xb_add(&bar[XB_TOP], 1u);
            const unsigned tg = og / nx;
            if (og + 1u == (tg + 1u) * nx) xb_add(&bar[XB_TOPGEN], 1u);
            else XB_SPIN(xb_ld(&bar[XB_TOPGEN]) == tg, bar);
            __builtin_amdgcn_fence(__ATOMIC_ACQUIRE, "agent");
            xb_add(&bar[XB_XGEN(bx_)], 1u);
            asm volatile("s_waitcnt vmcnt(0)" ::: "memory");
        } else {
            XB_SPIN(xb_ld(&bar[XB_XGEN(bx_)]) == gen, bar);
            __builtin_amdgcn_fence(__ATOMIC_ACQUIRE, "agent");
            asm volatile("s_waitcnt vmcnt(0)" ::: "memory");
        }
    }
    __syncthreads();
}

struct Args { const void* in[29]; float* out; unsigned char* ws; int ph_lo, ph_hi, l_lo, l_hi, li, do_final; };
__device__ __forceinline__ float wave_sum(float v) {
#pragma unroll
    for (int o = 1; o < 64; o <<= 1) v += __shfl_xor(v, o);
    return v;
}
__device__ __forceinline__ unsigned pk2(float lo, float hi) { return cvt_pk_bf16(lo, hi); }

__device__ __forceinline__ int w_row_map(int kind, int row_off, int n0) {
    if (kind == 0) return row_off + n0;
    if (kind == 1) {
        if (n0 < 3584) return n0;
        if (n0 < 4096) { const int j = (n0 - 3584) >> 7, r = (n0 - 3584) & 127; return 3584 + 256 * j + r; }
        if (n0 < 4608) { const int j = (n0 - 4096) >> 7, r = (n0 - 4096) & 127; return 3584 + 256 * j + 128 + r; }
        if (n0 < 5632) return n0;
        if (n0 < 5664) return 6656 + (n0 - 5632);
        if (n0 < 6176) { const int j = (n0 - 5664) >> 7, r = (n0 - 5664) & 127; return 5632 + 256 * j + r; }
        { const int j = (n0 - 6176) >> 7, r = (n0 - 6176) & 127; return 5632 + 256 * j + 128 + r; }
    }
    const int j = n0 >> 7, r = n0 & 127;
    return row_off + 256 * j + (kind == 3 ? 128 : 0) + r;
}
__device__ __forceinline__ void w_transpose_item(const float* W, int K, int N, bf16* WT, int kind, int row_off, const float* gain, LAS float* scr, int item, int lane) {
    const int nblk = N / 32, kb = item / nblk, nb = item - kb * nblk, k0 = 64 * kb, n0 = 32 * nb;
#pragma unroll 8
    for (int i = 0; i < 32; ++i) { const int kk = 2 * i + (lane >> 5); float v = W[(size_t)(k0 + kk) * N + n0 + (lane & 31)]; if (gain) v *= gain[k0 + kk]; scr[kk * 33 + (lane & 31)] = v; }
    LDS_WAIT(); asm volatile("" ::: "memory");
    const int c = lane & 7; const int drow = w_row_map(kind, row_off, n0);
#pragma unroll
    for (int j = 0; j < 4; ++j) { const int n = (lane >> 3) + 8 * j; const LAS float* s = scr + (8 * c) * 33 + n;
        v4u o; o.x = pk2(s[0 * 33], s[1 * 33]); o.y = pk2(s[2 * 33], s[3 * 33]); o.z = pk2(s[4 * 33], s[5 * 33]); o.w = pk2(s[6 * 33], s[7 * 33]);
        *(v4u*)(WT + (size_t)(drow + n) * K + k0 + 8 * c) = o; }
    LDS_WAIT(); asm volatile("" ::: "memory");
}
typedef const __attribute__((address_space(4))) unsigned char* kaptr;
__device__ __forceinline__ kaptr ka_get() { kaptr p = (kaptr)__builtin_amdgcn_kernarg_segment_ptr(); asm volatile("" : "+s"(p)); return p; }
__device__ __forceinline__ const float* ka_in(kaptr ka, int idx) { return (const float*)(*(const __attribute__((address_space(4))) unsigned long long*)(ka + 8 * idx)); }
__device__ __forceinline__ float* ka_out(kaptr ka) { return (float*)(*(const __attribute__((address_space(4))) unsigned long long*)(ka + 8 * 29)); }
__device__ __forceinline__ unsigned char* ka_ws(kaptr ka) { return (unsigned char*)(*(const __attribute__((address_space(4))) unsigned long long*)(ka + 8 * 30)); }
__device__ __forceinline__ int ka_int(kaptr ka, int i) { return *(const __attribute__((address_space(4))) int*)(ka + 248 + 4 * i); }
__device__ __forceinline__ int get_bx() { int bx = blockIdx.x; asm volatile("" : "+s"(bx)); return bx; }
__device__ __forceinline__ int get_G() { int G = gridDim.x; asm volatile("" : "+s"(G)); return G; }
__device__ __forceinline__ int get_vcu() { const int G = get_G(), bx = get_bx(); return (G % 8 == 0) ? (bx % 8) * (G / 8) + bx / 8 : bx; }
struct Tid { int tid, lane, wave; };
__device__ __forceinline__ Tid get_tid() { Tid t; t.tid = threadIdx.x; asm volatile("" : "+v"(t.tid)); t.lane = t.tid & 63; t.wave = __builtin_amdgcn_readfirstlane(t.tid >> 6); return t; }

#define KIN(idx, stride) (ka_in(ka, (idx)) + (size_t)L * (stride))

__device__ __forceinline__ void phase_w(kaptr ka, int L, LAS unsigned char* lds) {
    const Tid T = get_tid(); const int vcu = get_vcu(), G = get_G();
    unsigned char* ws = ka_ws(ka); unsigned char* wb = ws + WS_W;
    LAS float* scr = (LAS float*)(lds + T.wave * 16384);
    const int gw = vcu * NWAVES + T.wave, NGW = G * NWAVES;
    constexpr int I_IN = 16 * (INC / 32), I_OX = 8 * 32, I_UQ = 12 * 24, I_UKV = 4 * 32, I_O = 16 * 32, I_EG = 32 * 128, I_ED = 32 * 128, I_PG = 16 * 32, I_PLE = 4 * 32;
    constexpr int NITEMS = I_IN + 3 * I_OX + I_UQ + I_UKV + I_O + 2 * I_EG + I_ED + I_PG + I_PLE;
    for (int it = gw; it < NITEMS; it += NGW) {
        int r = it; const float* src; int K, N, kind = 0, roff = 0; size_t dsto; const float* gain = nullptr;
        if (r < I_IN) { src = KIN(4, (size_t)D * INC); K = 1024; N = INC; dsto = WO_IN; kind = 1; gain = KIN(3, D); }
        else if ((r -= I_IN) < I_OX) { src = KIN(6, 512 * D); K = 512; N = 1024; dsto = WO_OUTA; }
        else if ((r -= I_OX) < I_OX) { src = KIN(15, 512 * D); K = 512; N = 1024; dsto = WO_OUTC; }
        else if ((r -= I_OX) < I_OX) { src = KIN(11, 512 * D); K = 512; N = 1024; dsto = WO_OUTB; }
        else if ((r -= I_OX) < I_UQ) { src = KIN(8, 768 * 768); K = 768; N = 768; dsto = WO_UQ; gain = KIN(7, 768); }
        else if ((r -= I_UQ) < I_UKV) { src = KIN(10, 256 * 1024); K = 256; N = 1024; dsto = WO_UKV; gain = KIN(9, 256); }
        else if ((r -= I_UKV) < I_O) { src = KIN(16, D * D); K = 1024; N = 1024; dsto = WO_O; }
        else if ((r -= I_O) < I_EG) { const int e = r >> 7; r &= 127; src = KIN(22, (size_t)32 * D * 256) + (size_t)e * D * 256; K = 1024; N = 256; dsto = WO_GU; kind = 2; roff = e * 512; gain = KIN(17, D); }
        else if ((r -= I_EG) < I_EG) { const int e = r >> 7; r &= 127; src = KIN(23, (size_t)32 * D * 256) + (size_t)e * D * 256; K = 1024; N = 256; dsto = WO_GU; kind = 3; roff = e * 512; gain = KIN(17, D); }
        else if ((r -= I_EG) < I_ED) { const int e = r >> 7; r &= 127; src = KIN(24, (size_t)32 * 256 * D) + (size_t)e * 256 * D; K = 256; N = 1024; dsto = WO_DN; roff = e * 1024; }
        else if ((r -= I_ED) < I_PG) { src = KIN(26, D * D); K = 1024; N = 1024; dsto = WO_PG; gain = KIN(25, D); }
        else { r -= I_PG; src = KIN(27, 256 * D); K = 256; N = 1024; dsto = WO_PLE; }
        w_transpose_item(src, K, N, (bf16*)(wb + dsto), kind, roff, gain, scr, r, T.lane);
    }
    const int gt = vcu * 512 + T.tid, NGT = G * 512;
    { float* WR = (float*)(wb + WO_WR); const float* g = KIN(17, D); const float* wrg = KIN(18, D * 4); const float* wre = KIN(20, D * 32);
      for (int i = gt; i < 36 * 1024; i += NGT) { const int c = i >> 10, k = i & 1023; WR[i] = g[k] * (c < 4 ? wrg[k * 4 + c] : wre[k * 32 + (c - 4)]); } }
    { bf16* P16 = (bf16*)(ws + WS_P16); const float* p = KIN(1, (size_t)M * 256);
      for (int i = gt; i < M * 256 / 8; i += NGT) { const f32x4 a0 = ((const f32x4*)p)[2 * i], a1 = ((const f32x4*)p)[2 * i + 1];
        v4u o; o.x = pk2(a0[0], a0[1]); o.y = pk2(a0[2], a0[3]); o.z = pk2(a1[0], a1[1]); o.w = pk2(a1[2], a1[3]); ((v4u*)P16)[i] = o; } }
}
__device__ __forceinline__ void phase_cossin(kaptr ka) {
    const Tid T = get_tid(); unsigned char* ws = ka_ws(ka); const int gt = get_vcu() * 512 + T.tid, NGT = get_G() * 512;
    f32x2* cs = (f32x2*)(ws + WS_SMALL + SM_COSSIN); const int* pos = (const int*)ka_in(ka, 2);
    for (int i = gt; i < M * 16; i += NGT) { const int row = i >> 4, k = i & 15; const double ang = (double)pos[row] * pow(10000.0, -(double)k / 16.0); cs[i] = (f32x2){(float)cos(ang), (float)sin(ang)}; }
}
__device__ __forceinline__ void norm_row_bf16(const float* xrow, bf16* orow, int lane) {
    const f32x4* xr = (const f32x4*)xrow + lane;
    f32x4 v[4]; float s = 0.f;
#pragma unroll
    for (int j = 0; j < 4; ++j) { v[j] = xr[64 * j]; s += (v[j].x * v[j].x + v[j].y * v[j].y) + (v[j].z * v[j].z + v[j].w * v[j].w); }
    const float rstd = 1.f / sqrtf(wave_sum(s) * (1.f / D) + EPS);
    v2u* o8 = (v2u*)orow + lane;
#pragma unroll
    for (int j = 0; j < 4; ++j) { v2u w; w.x = pk2(v[j].x * rstd, v[j].y * rstd); w.y = pk2(v[j].z * rstd, v[j].w * rstd); o8[64 * j] = w; }
}
__device__ __forceinline__ void phase_n1(kaptr ka, int L) {
    const Tid T = get_tid(); const int gw = get_vcu() * NWAVES + T.wave, NGW = get_G() * NWAVES;
    const float* X = (L == 0) ? ka_in(ka, 0) : (const float*)ka_out(ka); bf16* XN = (bf16*)(ka_ws(ka) + WS_XN);
    for (int m = gw; m < M; m += NGW) norm_row_bf16(X + (size_t)m * D, XN + (size_t)m * D, T.lane);
}

__device__ __forceinline__ void phase_e1(kaptr ka, int L, LAS unsigned char* lds) {
    const Tid T = get_tid(); const int vcu = get_vcu(), G = get_G();
    unsigned char* ws = ka_ws(ka); unsigned char* R = ws + WS_R;
    const bf16* SCB = (const bf16*)(R + R_SCB); const bf16* CU = (const bf16*)(R + R_CU); const bf16* U = (const bf16*)(R + R_U);
    const bf16* QL = (const bf16*)(R + R_QL); const bf16* KVL = (const bf16*)(R + R_KVL); const bf16* KRR = (const bf16*)(R + R_KRR);
    bf16* KROPE = (bf16*)(R + R_KROPE); bf16* AIN = (bf16*)(R + R_AIN); bf16* CIN = (bf16*)(R + R_CIN);
    float* RSTDQ = (float*)(ws + WS_SMALL + SM_RSTDQ); float* RSTDKV = (float*)(ws + WS_SMALL + SM_RSTDKV);
    const f32x2* COSSIN = (const f32x2*)(ws + WS_SMALL + SM_COSSIN);
    const float* conv_c_w = KIN(12, 31 * 512); const float* conv_a_w = KIN(5, 3 * 512); const float* ln_c_g = KIN(13, 512); const float* ln_c_b = KIN(14, 512);
    LAS float* ldsf = (LAS float*)lds;
    const int tid = T.tid, cp = tid & 255, hb = tid >> 8, lane = T.lane;
    f32x2 w[31];
#pragma unroll
    for (int k = 0; k < 31; ++k) w[k] = *(const f32x2*)((const char*)conv_c_w + (unsigned)(k * 2048 + 8 * cp));
#pragma unroll 1
    for (int item = vcu; item < M / 64; item += G) {
        const int row0 = item * 64, t0 = row0 & (S - 1), seq0 = row0 - t0;
        {
            f32x2 acc[32];
#pragma unroll
            for (int j = 0; j < 32; ++j) acc[j] = (f32x2){0.f, 0.f};
            const int tb = t0 + 32 * hb - 30;
            const char* Useq = (const char*)(U + (size_t)seq0 * 512); const unsigned cp4 = 4u * cp;
#pragma unroll
            for (int rc = 0; rc < 64; rc += 16) {
                f32x2 uv[16]; int tbc = tb; asm volatile("" : "+v"(tbc));
#pragma unroll
                for (int q = 0; q < 16; ++q) { const int r = rc + q; if (r < 62) { const int tin = tbc + r; const int tcl = tin < 0 ? 0 : tin;
                        const unsigned v = *(const unsigned*)(Useq + ((unsigned)tcl * 1024u + cp4)); const float msk = tin < 0 ? 0.f : 1.f; uv[q] = (f32x2){bf_lo(v) * msk, bf_hi(v) * msk}; } }
#pragma unroll
                for (int q = 0; q < 16; ++q) { const int r = rc + q; if (r < 62) {
#pragma unroll
                        for (int j = 0; j < 32; ++j) { const int k = r - j; if (k >= 0 && k <= 30) acc[j] += w[k] * uv[q]; } } }
                asm volatile("" ::: "memory");
            }
#pragma unroll
            for (int j = 0; j < 32; ++j) *(LAS f32x2*)(ldsf + (32 * hb + j) * 512 + 2 * cp) = acc[j];
        }
        __syncthreads();
        {
            f32x4 g0 = *(const f32x4*)(ln_c_g + 8 * lane), g1 = *(const f32x4*)(ln_c_g + 8 * lane + 4), b0 = *(const f32x4*)(ln_c_b + 8 * lane), b1 = *(const f32x4*)(ln_c_b + 8 * lane + 4);
#pragma unroll 2
            for (int i = 0; i < 8; ++i) { const int tok = T.wave * 8 + i;
                f32x4 v0 = *(const LAS f32x4*)(ldsf + tok * 512 + 8 * lane), v1 = *(const LAS f32x4*)(ldsf + tok * 512 + 8 * lane + 4);
                const float mean = wave_sum((v0.x + v0.y) + (v0.z + v0.w) + (v1.x + v1.y) + (v1.z + v1.w)) * (1.f / 512.f);
                v0 = v0 - mean; v1 = v1 - mean;
                const float var = wave_sum((v0.x * v0.x + v0.y * v0.y) + (v0.z * v0.z + v0.w * v0.w) + (v1.x * v1.x + v1.y * v1.y) + (v1.z * v1.z + v1.w * v1.w)) * (1.f / 512.f);
                const float rstd = 1.f / sqrtf(var + EPS);
                v0 = v0 * rstd * g0 + b0; v1 = v1 * rstd * g1 + b1;
#pragma unroll
                for (int j = 0; j < 4; ++j) { v0[j] *= fsigmoid(v0[j]); v1[j] *= fsigmoid(v1[j]); }
                v4u o; o.x = pk2(v0.x, v0.y); o.y = pk2(v0.z, v0.w); o.z = pk2(v1.x, v1.y); o.w = pk2(v1.z, v1.w);
                *(v4u*)(CIN + (size_t)(row0 + tok) * 512 + 8 * lane) = o; }
        }
        {
            const f32x2 w0 = *(const f32x2*)(conv_a_w + 2 * cp), w1 = *(const f32x2*)(conv_a_w + 512 + 2 * cp), w2 = *(const f32x2*)(conv_a_w + 1024 + 2 * cp);
            const int tA = t0 + 32 * hb;
            f32x2 c2, c1;
            { const int ta = tA - 2, tb2 = tA - 1; const unsigned va = *(const unsigned*)(CU + (size_t)(seq0 + (ta < 0 ? 0 : ta)) * 512 + 2 * cp), vb = *(const unsigned*)(CU + (size_t)(seq0 + (tb2 < 0 ? 0 : tb2)) * 512 + 2 * cp);
              const float ma = ta < 0 ? 0.f : 1.f, mb = tb2 < 0 ? 0.f : 1.f; c2 = (f32x2){bf_lo(va) * ma, bf_hi(va) * ma}; c1 = (f32x2){bf_lo(vb) * mb, bf_hi(vb) * mb}; }
            const char* CUs = (const char*)(CU + (size_t)seq0 * 512); const char* SCBs = (const char*)(SCB + (size_t)seq0 * 512); char* AINs = (char*)(AIN + (size_t)seq0 * 512);
#pragma unroll 8
            for (int j = 0; j < 32; ++j) { const unsigned ro = (unsigned)(tA + j) * 1024u + 4u * cp;
                const unsigned vc = *(const unsigned*)(CUs + ro), vs = *(const unsigned*)(SCBs + ro);
                const f32x2 c0 = (f32x2){bf_lo(vc), bf_hi(vc)}; const f32x2 a = (w0 * c2 + w1 * c1 + w2 * c0) * (f32x2){bf_lo(vs), bf_hi(vs)};
                *(unsigned*)(AINs + ro) = pk2(a.x, a.y); c2 = c1; c1 = c0; }
        }
#pragma unroll
        for (int q = 0; q < 2; ++q) { const int idx = tid + 512 * q, tok = idx >> 4, i = idx & 15; const size_t row = row0 + tok;
            const float x1 = bf_lo((unsigned)KRR[row * 32 + i]), x2 = bf_lo((unsigned)KRR[row * 32 + 16 + i]); const f32x2 cs = COSSIN[row * 16 + i];
            KROPE[row * 32 + i] = (bf16)(pk2(x1 * cs.x - x2 * cs.y, 0.f) & 0xffffu); KROPE[row * 32 + 16 + i] = (bf16)(pk2(x1 * cs.y + x2 * cs.x, 0.f) & 0xffffu); }
#pragma unroll 2
        for (int i = 0; i < 8; ++i) { const size_t row = row0 + T.wave * 8 + i;
            const v2u* qp = (const v2u*)(QL + row * 768) + 3 * lane; float s = 0.f;
#pragma unroll
            for (int j = 0; j < 3; ++j) { const v2u w = qp[j]; const float a = bf_lo(w.x), b = bf_hi(w.x), c = bf_lo(w.y), d = bf_hi(w.y); s += (a * a + b * b) + (c * c + d * d); }
            const v2u kw = *((const v2u*)(KVL + row * 256) + lane); const float a = bf_lo(kw.x), b = bf_hi(kw.x), c = bf_lo(kw.y), d = bf_hi(kw.y);
            const float s2 = (a * a + b * b) + (c * c + d * d);
            const float sq = wave_sum(s), sk = wave_sum(s2);
            if (lane == 0) { RSTDQ[row] = 1.f / sqrtf(sq * (1.f / 768.f) + EPS); RSTDKV[row] = 1.f / sqrtf(sk * (1.f / 256.f) + EPS); } }
        __syncthreads();
    }
}

__device__ __forceinline__ void moe_tables(unsigned char* ws, int L, LAS unsigned char* lds) {
    LAS int* off = (LAS int*)(lds + LT_OFF); LAS int* tile = (LAS int*)(lds + LT_TILE); LAS int* ntp = (LAS int*)(lds + LT_NT);
    gu32* ctl = (gu32*)(ws + WS_CTL);
    __syncthreads();
    if (threadIdx.x == 0) { int o = 0, nt = 0;
#pragma unroll 1
        for (int e = 0; e < 32; ++e) { const int cnt = (int)__hip_atomic_load(ctl + CW_CNT + (L * 32 + e) * 16, RLX_AGENT); off[e] = o; const int n = (cnt + 255) >> 8;
#pragma unroll 1
            for (int k = 0; k < n && nt + k < MOE_TILES; ++k) tile[nt + k] = e;
            nt += n; o += n * 256; }
        off[32] = o; ntp[0] = nt < MOE_TILES ? nt : MOE_TILES; }
    __syncthreads();
}
__device__ __forceinline__ void phase_n2(kaptr ka, int L, LAS unsigned char* lds) {
    const Tid T = get_tid(); const int vcu = get_vcu(), G = get_G();
    unsigned char* ws = ka_ws(ka); gu32* ctl = (gu32*)(ws + WS_CTL);
    const float* X = ka_out(ka); bf16* XN = (bf16*)(ws + WS_XN); const float* WR = (const float*)(ws + WS_W + WO_WR);
    const float* b_rg = KIN(19, 4); const float* b_re = KIN(21, 32);
    int* SELE = (int*)(ws + WS_SMALL + SM_SELE); int* SELR = (int*)(ws + WS_SMALL + SM_SELR); float* WT = (float*)(ws + WS_SMALL + SM_WT); int* BASE = (int*)(ws + WS_SMALL + SM_BASE);
    LAS int* hist = (LAS int*)(lds + LT_HIST);
    const int lane = T.lane, gw = vcu * NWAVES + T.wave, NGW = G * NWAVES;
    __syncthreads();
    if (T.tid < 32) hist[T.tid] = 0;
    __syncthreads();
    for (int m0 = gw * 4; m0 < M; m0 += NGW * 4) {
        f32x4 xv[4][4]; float rs[4];
#pragma unroll
        for (int r = 0; r < 4; ++r) { const f32x4* xr = (const f32x4*)(X + (size_t)(m0 + r) * D) + lane; float s = 0.f;
#pragma unroll
            for (int j = 0; j < 4; ++j) { xv[r][j] = xr[64 * j]; s += (xv[r][j].x * xv[r][j].x + xv[r][j].y * xv[r][j].y) + (xv[r][j].z * xv[r][j].z + xv[r][j].w * xv[r][j].w); }
            rs[r] = 1.f / sqrtf(wave_sum(s) * (1.f / D) + EPS);
            v2u* o8 = (v2u*)(XN + (size_t)(m0 + r) * D) + lane;
#pragma unroll
            for (int j = 0; j < 4; ++j) { v2u w; w.x = pk2(xv[r][j].x * rs[r], xv[r][j].y * rs[r]); w.y = pk2(xv[r][j].z * rs[r], xv[r][j].w * rs[r]); o8[64 * j] = w; } }
        float lg[4] = {0.f, 0.f, 0.f, 0.f};
#pragma unroll 2
        for (int c = 0; c < 36; ++c) { const f32x4* wr = (const f32x4*)(WR + c * 1024) + lane; f32x4 wv[4];
#pragma unroll
            for (int j = 0; j < 4; ++j) wv[j] = wr[64 * j];
#pragma unroll
            for (int r = 0; r < 4; ++r) { float d = 0.f;
#pragma unroll
                for (int j = 0; j < 4; ++j) d += (xv[r][j].x * wv[j].x + xv[r][j].y * wv[j].y) + (xv[r][j].z * wv[j].z + xv[r][j].w * wv[j].w);
                d = wave_sum(d); if (lane == c) lg[r] = d * rs[r]; } }
        const float bias = lane < 4 ? b_rg[lane] : (lane < 36 ? b_re[lane - 4] : 0.f);
#pragma unroll
        for (int r = 0; r < 4; ++r) { const float v = lg[r] + bias;
            float gl[4]; float gm = -INFINITY; int gs = 0;
#pragma unroll
            for (int k = 0; k < 4; ++k) { gl[k] = __shfl(v, k); if (gl[k] > gm) { gm = gl[k]; gs = k; } }
            float gsum = 0.f;
#pragma unroll
            for (int k = 0; k < 4; ++k) gsum += expf(gl[k] - gm);
            const float p_sel = 1.0f / gsum;
            float el[8]; float em = -INFINITY;
#pragma unroll
            for (int e = 0; e < 8; ++e) { el[e] = __shfl(v, 4 + gs * 8 + e); em = fmaxf(em, el[e]); }
            int i0 = 0; float p0 = -1.f;
#pragma unroll
            for (int e = 0; e < 8; ++e) { el[e] = expf(el[e] - em); if (el[e] > p0) { p0 = el[e]; i0 = e; } }
            int i1 = 0; float p1 = -1.f;
#pragma unroll
            for (int e = 0; e < 8; ++e) if (e != i0 && el[e] > p1) { p1 = el[e]; i1 = e; }
            if (lane == 0) { const int row = m0 + r, e0 = gs * 8 + i0, e1 = gs * 8 + i1; const float tot = p0 + p1;
                SELE[row * 2] = e0; SELE[row * 2 + 1] = e1;
                SELR[row * 2] = __hip_atomic_fetch_add(&hist[e0], 1, __ATOMIC_RELAXED, __HIP_MEMORY_SCOPE_WORKGROUP); SELR[row * 2 + 1] = __hip_atomic_fetch_add(&hist[e1], 1, __ATOMIC_RELAXED, __HIP_MEMORY_SCOPE_WORKGROUP);
                WT[row * 2] = p0 / tot * p_sel; WT[row * 2 + 1] = p1 / tot * p_sel; } }
    }
    __syncthreads();
    if (T.tid < 32) { const int c = hist[T.tid]; int base = 0; if (c > 0) base = (int)__hip_atomic_fetch_add(ctl + CW_CNT + (L * 32 + T.tid) * 16, (unsigned)c, RLX_AGENT); BASE[vcu * 32 + T.tid] = base; }
    __syncthreads();
}
__device__ __forceinline__ void phase_r1(kaptr ka, int L, LAS unsigned char* lds) {
    const Tid T = get_tid(); const int vcu = get_vcu(), G = get_G();
    unsigned char* ws = ka_ws(ka);
    const int* SELE = (const int*)(ws + WS_SMALL + SM_SELE); const int* SELR = (const int*)(ws + WS_SMALL + SM_SELR); const float* WT = (const float*)(ws + WS_SMALL + SM_WT);
    const int* BASE = (const int*)(ws + WS_SMALL + SM_BASE); int* TOKPOS = (int*)(ws + WS_SMALL + SM_TOKPOS); float* ROWW = (float*)(ws + WS_SMALL + SM_ROWW);
    const bf16* XN = (const bf16*)(ws + WS_XN); bf16* XG = (bf16*)(ws + WS_R + R_XG);
    moe_tables(ws, L, lds);
    const LAS int* off = (const LAS int*)(lds + LT_OFF);
    const int lane = T.lane, gw = vcu * NWAVES + T.wave, NGW = G * NWAVES;
    for (int m0 = gw * 4; m0 < M; m0 += NGW * 4) {
#pragma unroll
        for (int r = 0; r < 4; ++r) { const int row = m0 + r; const v4u* src = (const v4u*)(XN + (size_t)row * D); const v4u a = src[lane], b = src[64 + lane];
#pragma unroll
            for (int s = 0; s < 2; ++s) { const int e = SELE[row * 2 + s]; int pos = off[e] + BASE[vcu * 32 + e] + SELR[row * 2 + s]; pos = pos < MOE_ROWS ? pos : MOE_ROWS - 1;
                v4u* dst = (v4u*)(XG + (size_t)pos * D); dst[lane] = a; dst[64 + lane] = b;
                if (lane == 0) { ROWW[pos] = WT[row * 2 + s]; TOKPOS[row * 2 + s] = pos; } } }
    }
}
__device__ __forceinline__ void phase_n3(kaptr ka) {
    const Tid T = get_tid(); unsigned char* ws = ka_ws(ka); float* X = ka_out(ka); bf16* XN = (bf16*)(ws + WS_XN);
    const int* TOKPOS = (const int*)(ws + WS_SMALL + SM_TOKPOS); const bf16* Y = (const bf16*)(ws + WS_R + R_Y);
    const int lane = T.lane, gw = get_vcu() * NWAVES + T.wave, NGW = get_G() * NWAVES;
    for (int m = gw; m < M; m += NGW) {
        const int p0 = TOKPOS[m * 2], p1 = TOKPOS[m * 2 + 1];
        f32x4* xr = (f32x4*)(X + (size_t)m * D) + lane; const v2u* y0 = (const v2u*)(Y + (size_t)p0 * D) + lane; const v2u* y1 = (const v2u*)(Y + (size_t)p1 * D) + lane;
        f32x4 v[4]; float s = 0.f;
#pragma unroll
        for (int j = 0; j < 4; ++j) { const v2u a = y0[64 * j], b = y1[64 * j]; v[j] = xr[64 * j];
            v[j].x += bf_lo(a.x) + bf_lo(b.x); v[j].y += bf_hi(a.x) + bf_hi(b.x); v[j].z += bf_lo(a.y) + bf_lo(b.y); v[j].w += bf_hi(a.y) + bf_hi(b.y);
            xr[64 * j] = v[j]; s += (v[j].x * v[j].x + v[j].y * v[j].y) + (v[j].z * v[j].z + v[j].w * v[j].w); }
        const float rstd = 1.f / sqrtf(wave_sum(s) * (1.f / D) + EPS);
        v2u* o8 = (v2u*)(XN + (size_t)m * D) + lane;
#pragma unroll
        for (int j = 0; j < 4; ++j) { v2u w; w.x = pk2(v[j].x * rstd, v[j].y * rstd); w.y = pk2(v[j].z * rstd, v[j].w * rstd); o8[64 * j] = w; }
    }
}
__device__ __forceinline__ void phase_final(kaptr ka) {
    const Tid T = get_tid(); float* X = ka_out(ka); const float* g = ka_in(ka, 28);
    const int lane = T.lane, gw = get_vcu() * NWAVES + T.wave, NGW = get_G() * NWAVES;
    for (int m = gw; m < M; m += NGW) {
        f32x4* xr = (f32x4*)(X + (size_t)m * D) + lane; f32x4 v[4]; float s = 0.f;
#pragma unroll
        for (int j = 0; j < 4; ++j) { v[j] = xr[64 * j]; s += (v[j].x * v[j].x + v[j].y * v[j].y) + (v[j].z * v[j].z + v[j].w * v[j].w); }
        const float rstd = 1.f / sqrtf(wave_sum(s) * (1.f / D) + EPS);
#pragma unroll
        for (int j = 0; j < 4; ++j) xr[64 * j] = v[j] * rstd * ((const f32x4*)g)[64 * j + lane];
    }
}

__device__ __forceinline__ bool in_range(int k) { kaptr ka = ka_get(); return ka_int(ka, 0) <= k && k < ka_int(ka, 1); }
constexpr int NPHASE = 13;
__global__ void __launch_bounds__(NWAVES * 64, 2) mk_fwd(Args args) {
    extern __shared__ __attribute__((aligned(16))) unsigned char lds_raw[];
    LAS unsigned char* lds = (LAS unsigned char*)lds_raw;
    for (int u = threadIdx.x; u < (LDS_BYTES - LDSCTL_OFF) / 4; u += NWAVES * 64) ((LAS unsigned*)(lds + LDSCTL_OFF))[u] = 0u;
    __syncthreads();
    XcdBarrier bar;
    { kaptr ka = ka_get(); bar = xcd_barrier_post((unsigned*)(ka_ws(ka) + WS_CTL) + CW_BAR + ka_int(ka, 4) * XCD_BAR_WORDS, (volatile LAS unsigned*)(lds + MISC_OFF) + 8); }
#define IN(k) in_range(k)
    { kaptr ka = ka_get(); if (ka_int(ka, 2) == 0 && ka_int(ka, 0) == 0) phase_cossin(ka); }
#define GRID_BAR() xcd_barrier(bar)
#define WPTR(off) ((const bf16*)(ws + WS_W + (off)))
#define RPTR(off) ((bf16*)(ws + WS_R + (off)))
    const int l_hi = args.l_hi;
#pragma unroll 1
    for (int L = args.l_lo; L < l_hi; ++L) {
        if (IN(0)) { kaptr ka = ka_get(); phase_w(ka, L, lds); phase_n1(ka, L); GRID_BAR(); }
        if (IN(1)) { kaptr ka = ka_get(); unsigned char* ws = ka_ws(ka);
            pg8::Gemm g{(const bf16*)(ws + WS_XN), WPTR(WO_IN), D, D, D}; pg8::StaticOrder S_; S_.init(M, INC_PAD, get_G(), get_bx());
            pg8::EpiInProj E{ws + WS_R}; pg8::gemm_phase<pg8::EpiInProj, pg8::StaticOrder>(lds, g, S_, E); GRID_BAR(); }
        if (IN(2)) { kaptr ka = ka_get(); phase_e1(ka, L, lds); GRID_BAR(); }
        if (IN(3)) {
            { kaptr ka = ka_get(); unsigned char* ws = ka_ws(ka); pg8::Gemm g{RPTR(R_AIN), WPTR(WO_OUTA), 512, 512, 512}; pg8::StaticOrder S_; S_.init(M, D, get_G(), get_bx());
              pg8::EpiGateRmw<true> E{RPTR(R_SG), 0}; pg8::gemm_phase<pg8::EpiGateRmw<true>, pg8::StaticOrder>(lds, g, S_, E); }
            { kaptr ka = ka_get(); unsigned char* ws = ka_ws(ka); pg8::Gemm g{RPTR(R_CIN), WPTR(WO_OUTC), 512, 512, 512}; pg8::StaticOrder S_; S_.init(M, D, get_G(), get_bx());
              pg8::EpiGateRmw<false> E{RPTR(R_SG), 2048}; pg8::gemm_phase<pg8::EpiGateRmw<false>, pg8::StaticOrder>(lds, g, S_, E); }
            { kaptr ka = ka_get(); unsigned char* ws = ka_ws(ka); pg8::Gemm g{RPTR(R_QL), WPTR(WO_UQ), 768, 768, 768}; pg8::StaticOrder S_; S_.init(M, 768, get_G(), get_bx());
              pg8::EpiQ E{ws}; pg8::gemm_phase<pg8::EpiQ, pg8::StaticOrder>(lds, g, S_, E); }
            { kaptr ka = ka_get(); unsigned char* ws = ka_ws(ka); pg8::Gemm g{RPTR(R_KVL), WPTR(WO_UKV), 256, 256, 256}; pg8::StaticOrder S_; S_.init(M, 1024, get_G(), get_bx());
              pg8::EpiKV E{ws}; pg8::gemm_phase<pg8::EpiKV, pg8::StaticOrder>(lds, g, S_, E); }
            GRID_BAR(); }
        if (IN(4)) { kaptr ka = ka_get(); unsigned char* ws = ka_ws(ka);
            const bf16* Qb = (const bf16*)(ws + WS_XN); const bf16* Kb = RPTR(R_SCB); const bf16* Vb = RPTR(R_CU); const bf16* Kr = RPTR(R_KROPE); bf16* AO = RPTR(R_AIN);
            for (int v = get_vcu(); v < 256; v += get_G()) { const int bh = v >> 2, s = v & 3;
                attn::attn_unit(bh >> 3, bh & 7, 7 - s, Qb, Kb, Kr, Vb, AO, (attn::lptr)lds);
                attn::attn_unit(bh >> 3, bh & 7, s, Qb, Kb, Kr, Vb, AO, (attn::lptr)lds); }
            GRID_BAR(); }
        if (IN(5)) { kaptr ka = ka_get(); unsigned char* ws = ka_ws(ka); pg8::Gemm g{RPTR(R_AIN), WPTR(WO_OUTB), 512, 512, 512}; pg8::StaticOrder S_; S_.init(M, D, get_G(), get_bx());
            pg8::EpiGateRmw<false> E{RPTR(R_SG), 1024}; pg8::gemm_phase<pg8::EpiGateRmw<false>, pg8::StaticOrder>(lds, g, S_, E); GRID_BAR(); }
        if (IN(6)) { kaptr ka = ka_get(); unsigned char* ws = ka_ws(ka); pg8::Gemm g{RPTR(R_SG), WPTR(WO_O), 3072, D, D}; pg8::StaticOrder S_; S_.init(M, D, get_G(), get_bx());
            float* Xs = ka_out(ka); pg8::EpiResF32 E{(L == 0) ? ka_in(ka, 0) : (const float*)Xs, Xs}; pg8::gemm_phase<pg8::EpiResF32, pg8::StaticOrder>(lds, g, S_, E); GRID_BAR(); }
        if (IN(7)) { kaptr ka = ka_get(); phase_n2(ka, L, lds); GRID_BAR(); }
        if (IN(8)) { kaptr ka = ka_get(); phase_r1(ka, L, lds); GRID_BAR(); }
        if (IN(9)) { kaptr ka = ka_get(); unsigned char* ws = ka_ws(ka); moe_tables(ws, L, lds); const int nt = *(const LAS int*)(lds + LT_NT);
            pg8::Gemm g{RPTR(R_XG), WPTR(WO_GU), D, D, D}; pg8::MoeOrder S_{(const LAS int*)(lds + LT_TILE), 2 * nt, 2, get_G(), get_bx()};
            pg8::EpiMoeGU E{ws}; pg8::gemm_phase<pg8::EpiMoeGU, pg8::MoeOrder>(lds, g, S_, E); GRID_BAR(); }
        if (IN(10)) { kaptr ka = ka_get(); unsigned char* ws = ka_ws(ka); moe_tables(ws, L, lds); const int nt = *(const LAS int*)(lds + LT_NT);
            pg8::Gemm g{RPTR(R_H), WPTR(WO_DN), 256, 256, 256}; pg8::MoeOrder S_{(const LAS int*)(lds + LT_TILE), 4 * nt, 4, get_G(), get_bx()};
            pg8::EpiStoreBf16 E{RPTR(R_Y), D, 3}; pg8::gemm_phase<pg8::EpiStoreBf16, pg8::MoeOrder>(lds, g, S_, E); GRID_BAR(); }
        if (IN(11)) { kaptr ka = ka_get(); phase_n3(ka); GRID_BAR(); }
        if (IN(12)) {
            { kaptr ka = ka_get(); unsigned char* ws = ka_ws(ka); pg8::Gemm g{(const bf16*)(ws + WS_P16), WPTR(WO_PLE), 256, 256, 256}; pg8::StaticOrder S_; S_.init(M, D, get_G(), get_bx());
              pg8::EpiStoreBf16 E{RPTR(R_XG), D, 0xffff}; pg8::gemm_phase<pg8::EpiStoreBf16, pg8::StaticOrder>(lds, g, S_, E); }
            { kaptr ka = ka_get(); unsigned char* ws = ka_ws(ka); pg8::Gemm g{(const bf16*)(ws + WS_XN), WPTR(WO_PG), D, D, D}; pg8::StaticOrder S_; S_.init(M, D, get_G(), get_bx());
              pg8::EpiPle E{ka_out(ka), ws}; pg8::gemm_phase<pg8::EpiPle, pg8::StaticOrder>(lds, g, S_, E); }
            GRID_BAR(); }
    }
    if (args.do_final) { kaptr ka = ka_get(); phase_final(ka); }
#undef IN
#undef GRID_BAR
#undef WPTR
#undef RPTR
}
#ifndef MK_CUT
#define MK_CUT 0
#endif
static void mk_launch(hipStream_t stream, int grid, Args a, int ph_lo, int ph_hi, int l_lo, int l_hi, int li, int do_final) {
    a.ph_lo = ph_lo; a.ph_hi = ph_hi; a.l_lo = l_lo; a.l_hi = l_hi; a.li = li; a.do_final = do_final;
    hipLaunchKernelGGL(mk_fwd, dim3(grid), dim3(NWAVES * 64), LDS_BYTES, stream, a);
}
extern "C" void kernel_launch(void* const* d_in, const int* in_sizes, int n_in, void* d_out, int out_size, void* d_ws, size_t ws_size, hipStream_t stream) {
    static int grid = 0;
    if (grid == 0) {
        if (n_in != 29 || out_size != M * D || ws_size < WS_END + 40 * MiB) { fprintf(stderr, "kernel_launch: unexpected shapes / workspace (%zu < %zu)\n", ws_size, (size_t)(WS_END + 40 * MiB)); grid = -1; return; }
        int dev = 0, cus = 0;
        if (hipGetDevice(&dev) != hipSuccess || hipDeviceGetAttribute(&cus, hipDeviceAttributeMultiprocessorCount, dev) != hipSuccess) { grid = -1; return; }
        if (hipFuncSetAttribute((const void*)mk_fwd, hipFuncAttributeMaxDynamicSharedMemorySize, LDS_BYTES) != hipSuccess) { grid = -1; return; }
        int per_cu = 0;
        if (hipOccupancyMaxActiveBlocksPerMultiprocessor(&per_cu, (const void*)mk_fwd, NWAVES * 64, LDS_BYTES) != hipSuccess || per_cu < 1) { fprintf(stderr, "kernel_launch: occupancy query says %d\n", per_cu); }
        (void)hipGetLastError();
        grid = cus;
    }
    if (grid < 0) return;
    (void)hipMemsetAsync((char*)d_ws + WS_CTL, 0, CTL_ZERO_BYTES, stream);
    Args a{};
    for (int i = 0; i < 29; ++i) a.in[i] = d_in[i];
    a.out = (float*)d_out; a.ws = (unsigned char*)d_ws;
#if defined(DUMP_K)
    mk_launch(stream, grid, a, 0, DUMP_K, 0, 1, 0, 0);
    hipLaunchKernelGGL(dbg_dump, dim3(M), dim3(256), 0, stream, (const unsigned char*)d_ws, (float*)d_out, (long long)DUMP_K);
#elif MK_CUT == 0
    mk_launch(stream, grid, a, 0, NPHASE, 0, DEPTH, 0, 1);
#elif MK_CUT == 3
    mk_launch(stream, grid, a, 0, NPHASE, 0, 1, 0, 0);
    mk_launch(stream, grid, a, 0, NPHASE, 1, 2, 1, 1);
#else
    {
        constexpr int MC = nv::MC;
        const float* p = (const float*)d_in[1];
        const float* ln_ffn_g = (const float*)d_in[17]; const float* w_rg = (const float*)d_in[18]; const float* b_rg = (const float*)d_in[19]; const float* w_re = (const float*)d_in[20]; const float* b_re = (const float*)d_in[21];
        const float* w_eg = (const float*)d_in[22]; const float* w_eu = (const float*)d_in[23]; const float* w_ed = (const float*)d_in[24];
        const float* ln_ple_g = (const float*)d_in[25]; const float* w_pg = (const float*)d_in[26]; const float* w_ple = (const float*)d_in[27]; const float* final_g = (const float*)d_in[28];
        float* X = (float*)d_out;
        float* nws = (float*)((char*)d_ws + WS_END);
        float* HN = nws; float* MG = HN + (size_t)MC * D; int* SEL = (int*)(MG + (size_t)MC * D); float* WTS = (float*)(SEL + MC * 2);
        for (int L = 0; L < DEPTH; ++L) {
            mk_launch(stream, grid, a, 0, MK_CUT == 1 ? 7 : 12, L, L + 1, L, 0);
            for (int c0 = 0; c0 < M; c0 += MC) {
                float* Xc = X + (size_t)c0 * D;
#if MK_CUT == 1
                hipLaunchKernelGGL(nv::rmsnorm_rows, dim3(MC), dim3(256), 0, stream, (const float*)Xc, (long long)D, (long long)D, ln_ffn_g + L * D, HN, (long long)D);
                hipLaunchKernelGGL(nv::route, dim3(MC), dim3(64), 0, stream, (const float*)HN, w_rg + (size_t)L * D * 4, b_rg + L * 4, w_re + (size_t)L * D * 32, b_re + L * 32, SEL, WTS);
                hipLaunchKernelGGL(nv::moe_tok, dim3(MC), dim3(256), 0, stream, (const float*)HN, (const int*)SEL, (const float*)WTS,
                                   w_eg + (size_t)L * 32 * D * 256, w_eu + (size_t)L * 32 * D * 256, w_ed + (size_t)L * 32 * 256 * D, Xc);
#endif
                hipLaunchKernelGGL(nv::rmsnorm_rows, dim3(MC), dim3(256), 0, stream, (const float*)Xc, (long long)D, (long long)D, ln_ple_g + L * D, HN, (long long)D);
                nv::launch_gemm(stream, HN, D, w_pg + (size_t)L * D * D, D, MC, D, D, nv::EStore{MG, D});
                nv::launch_gemm(stream, p + ((size_t)L * M + c0) * 256, 256, w_ple + (size_t)L * 256 * D, D, MC, D, 256, nv::EPle{Xc, MG});
            }
        }
        for (int c0 = 0; c0 < M; c0 += MC) { float* Xc = X + (size_t)c0 * D;
            hipLaunchKernelGGL(nv::rmsnorm_rows, dim3(MC), dim3(256), 0, stream, (const float*)Xc, (long long)D, (long long)D, final_g, Xc, (long long)D); }
    }
#endif
}
```

```cpp
#include <hip/hip_runtime.h>
#include <cstdio>
#include <cstdint>
#include <cmath>
#define MK_CUT 0
constexpr int NB = 8, S = 2048, M = NB * S, D = 1024, DEPTH = 2, NHEAD = 8;
constexpr int INC = 6688, INC_PAD = 6912;
constexpr float EPS = 1e-6f;
constexpr int NWAVES = 8;
constexpr int MOE_ROWS = 2 * M + 32 * 256;
constexpr int MOE_TILES = MOE_ROWS / 256;

#define GAS __attribute__((address_space(1)))
#define LAS __attribute__((address_space(3)))
typedef unsigned short bf16;
typedef unsigned v4u __attribute__((ext_vector_type(4)));
typedef unsigned v2u __attribute__((ext_vector_type(2)));
typedef float f32x4 __attribute__((ext_vector_type(4)));
typedef float f32x2 __attribute__((ext_vector_type(2)));
typedef GAS unsigned gu32;
#define RLX_AGENT __ATOMIC_RELAXED, __HIP_MEMORY_SCOPE_AGENT

constexpr size_t MiB = 1u << 20;
constexpr size_t WS_CTL = 0, CTL_ZERO_BYTES = 2 * MiB;
constexpr size_t WO_IN = 0;
constexpr size_t WO_OUTA = WO_IN + (size_t)INC_PAD * 1024 * 2;
constexpr size_t WO_OUTC = WO_OUTA + 1024 * 512 * 2;
constexpr size_t WO_OUTB = WO_OUTC + 1024 * 512 * 2;
constexpr size_t WO_UQ = WO_OUTB + 1024 * 512 * 2;
constexpr size_t WO_UKV = WO_UQ + 768 * 768 * 2;
constexpr size_t WO_O = WO_UKV + 1024 * 256 * 2;
constexpr size_t WO_GU = WO_O + 1024 * 1024 * 2;
constexpr size_t WO_DN = WO_GU + (size_t)32 * 512 * 1024 * 2;
constexpr size_t WO_PG = WO_DN + (size_t)32 * 1024 * 256 * 2;
constexpr size_t WO_PLE = WO_PG + 1024 * 1024 * 2;
constexpr size_t WO_WR = WO_PLE + 1024 * 256 * 2;
constexpr size_t WO_END = WO_WR + 2 * 48 * 1024 * 2;
constexpr size_t WS_W = 2 * MiB, WS_W_BYTES = 72 * MiB;
static_assert(WO_END <= WS_W_BYTES, "weight region");
constexpr size_t WS_SMALL = WS_W + WS_W_BYTES;
constexpr size_t SM_COSSIN = 0;
constexpr size_t SM_RSTDQ = 2 * MiB, SM_RSTDKV = SM_RSTDQ + M * 4;
constexpr size_t SM_SELE = SM_RSTDKV + M * 4;
constexpr size_t SM_SELR = SM_SELE + M * 8;
constexpr size_t SM_WT = SM_SELR + M * 8;
constexpr size_t SM_TOKPOS = SM_WT + M * 8;
constexpr size_t SM_BASE = SM_TOKPOS + M * 8;
constexpr size_t SM_ROWW = SM_BASE + 256 * 32 * 4;
constexpr size_t SM_END = SM_ROWW + (size_t)MOE_ROWS * 4;
static_assert(SM_END <= 4 * MiB, "small region");
constexpr size_t WS_XN = WS_SMALL + 4 * MiB;
constexpr size_t WS_P16 = WS_XN + 32 * MiB;
constexpr size_t WS_R = WS_P16 + 8 * MiB;
constexpr size_t R_SG = 0;
constexpr size_t R_SCB = R_SG + 96 * MiB;
constexpr size_t R_CU = R_SCB + 16 * MiB;
constexpr size_t R_U = R_CU + 16 * MiB;
constexpr size_t R_QL = R_U + 16 * MiB;
constexpr size_t R_KVL = R_QL + 24 * MiB;
constexpr size_t R_KRR = R_KVL + 8 * MiB;
constexpr size_t R_KROPE = R_KRR + 1 * MiB;
constexpr size_t R_AIN = R_KROPE + 1 * MiB;
constexpr size_t R_CIN = R_AIN + 16 * MiB;
constexpr size_t R_MIX_END = R_CIN + 16 * MiB;
constexpr size_t R_XG = 0;
constexpr size_t R_H = R_XG + (size_t)MOE_ROWS * 1024 * 2;
constexpr size_t R_Y = R_H + (size_t)MOE_ROWS * 256 * 2;
constexpr size_t R_MOE_END = R_Y + (size_t)MOE_ROWS * 1024 * 2;
constexpr size_t R_BYTES = R_MIX_END > R_MOE_END ? R_MIX_END : R_MOE_END;
constexpr size_t WS_END = WS_R + R_BYTES;
constexpr int CW_BAR = 4096;
constexpr int CW_CNT = 1024;
constexpr int RING_BYTES = 131072;
constexpr int LDSCTL_OFF = RING_BYTES, MISC_OFF = LDSCTL_OFF + 320;
constexpr int LT_HIST = LDSCTL_OFF + 1024;
constexpr int LT_BASE = LT_HIST + 128;
constexpr int LT_OFF = LT_BASE + 128;
constexpr int LT_TILE = LT_OFF + 160;
constexpr int LT_NT = LT_TILE + 640;
constexpr int LDS_BYTES = 147456;
static_assert(LT_NT + 16 <= LDS_BYTES, "LDS map");

namespace pg8 {
#define PG8_LAS __attribute__((address_space(3)))
typedef unsigned short bf16_t;
typedef short bf16x8 __attribute__((ext_vector_type(8)));
typedef float f32x4 __attribute__((ext_vector_type(4)));
typedef float f32x2 __attribute__((ext_vector_type(2)));
typedef unsigned u32x4 __attribute__((ext_vector_type(4)));
typedef unsigned u32x2 __attribute__((ext_vector_type(2)));
constexpr int BM = 256, BK = 64, HALF = 128, HTB = HALF * BK * 2  , STAGE_BYTES = 8 * HTB, NXCD = 8, WGM = 8;

__host__ __device__ __forceinline__ int lds_byte(int r, int c) { const int st = (r >> 4) * 2 + (c >> 5), rr = r & 15, cc = c & 31, ob = rr * 64 + cc * 2; return st * 1024 + (ob ^ (((ob >> 9) & 1) << 5)); }
__host__ __device__ __forceinline__ void stage_rc(int b, int& R, int& C) { const int st = b / 1024, sb = b % 1024, swz = sb ^ (((sb >> 9) & 1) << 5); R = (st >> 1) * 16 + swz / 64; C = (st & 1) * 32 + (swz % 64) / 2; }
__host__ __device__ __forceinline__ int perm32(int rho) { const int n = rho >> 4, i = rho & 15; return 8 * (i >> 2) + 4 * n + (i & 3); }

struct Unit { int pm, pn; };
struct Gemm { const bf16_t* A; const bf16_t* Bt; int lda, ldb, K; };

struct StaticOrder {
    int nM, nN, nwg, G, c;
    __device__ void init(int M, int N, int G_, int c_) { nM = M / BM; nN = N / BM; nwg = nM * nN; G = G_; c = c_; }
    __device__ bool next(int i, Unit& u) const {
        const long L = (long)i * G + c; if (L >= nwg) return false;
        int wgid = (int)L; { const int q = nwg / NXCD, r = nwg % NXCD, xcd = wgid % NXCD, off = wgid / NXCD; wgid = (xcd < r ? xcd * (q + 1) : r * (q + 1) + (xcd - r) * q) + off; }
        const int nig = WGM * nN, gid = wgid / nig, fm = gid * WGM, gsz = (nM - fm) < WGM ? (nM - fm) : WGM;
        u.pm = fm + ((wgid % nig) % gsz); u.pn = (wgid % nig) / gsz; return true;
    }
};
struct MoeOrder {
    const PG8_LAS int* tile_e; int nunits, ncol, G, c;
    __device__ bool next(int i, Unit& u) const {
        const int L = i * G + c; if (L >= nunits) return false;
        const int rt = L / ncol, ct = L - rt * ncol; u.pm = rt; u.pn = tile_e[rt] * ncol + ct; return true;
    }
};

typedef __bf16 bf16x2_t __attribute__((ext_vector_type(2)));
__device__ __forceinline__ unsigned cvt_pk_bf16(float lo, float hi) { const f32x2 v = {lo, hi}; const bf16x2_t b = __builtin_convertvector(v, bf16x2_t); return __builtin_bit_cast(unsigned, b); }
__device__ __forceinline__ float bf_lo(unsigned w) { return __uint_as_float(w << 16); }
__device__ __forceinline__ float bf_hi(unsigned w) { return __uint_as_float(w & 0xffff0000u); }
__device__ __forceinline__ float fsigmoid(float x) { return __builtin_amdgcn_rcpf(1.0f + __builtin_amdgcn_exp2f(-1.44269504089f * x)); }
__device__ __forceinline__ u32x4 pack8(const f32x4& a, const f32x4& b) { u32x4 w; w.x = cvt_pk_bf16(a[0], a[1]); w.y = cvt_pk_bf16(a[2], a[3]); w.z = cvt_pk_bf16(b[0], b[1]); w.w = cvt_pk_bf16(b[2], b[3]); return w; }
__device__ __forceinline__ void unpack8(const u32x4& w, f32x4& a, f32x4& b) { a = (f32x4){bf_lo(w.x), bf_hi(w.x), bf_lo(w.y), bf_hi(w.y)}; b = (f32x4){bf_lo(w.z), bf_hi(w.z), bf_lo(w.w), bf_hi(w.w)}; }

#define PG8_FOR_AI_M _Pragma("unroll") for (int ai = 0; ai < 2; ++ai) _Pragma("unroll") for (int m = 0; m < 4; ++m)

struct EpiInProj {
    static constexpr bool PERM = true;
    unsigned char* R;
    __device__ __forceinline__ void operator()(const f32x4 (&acc)[2][2][4][2], const Unit& u, int wr, int wc, int fr, int fq) const {
        const int row0 = u.pm * BM + wr * 64 + fr, pn = u.pn, cl = wc * 32 + 8 * fq;
        bf16_t* SG = (bf16_t*)(R + R_SG); bf16_t* SCB = (bf16_t*)(R + R_SCB); bf16_t* CU = (bf16_t*)(R + R_CU); bf16_t* QL = (bf16_t*)(R + R_QL);
        bf16_t* KVL = (bf16_t*)(R + R_KVL); bf16_t* U = (bf16_t*)(R + R_U); bf16_t* KRR = (bf16_t*)(R + R_KRR);
        if (pn < 12) {
            PG8_FOR_AI_M { bf16_t* rp = SG + (size_t)(row0 + ai * HALF + m * 16) * 3072 + pn * 256 + cl;
#pragma unroll
                for (int bj = 0; bj < 2; ++bj) { f32x4 a = acc[ai][bj][m][0], b = acc[ai][bj][m][1];
#pragma unroll
                    for (int j = 0; j < 4; ++j) { a[j] = fsigmoid(a[j]); b[j] = fsigmoid(b[j]); }
                    *(u32x4*)(rp + bj * HALF) = pack8(a, b); } }
        } else if (pn < 14) {
            PG8_FOR_AI_M { bf16_t* rp = SCB + (size_t)(row0 + ai * HALF + m * 16) * 512 + (pn - 12) * 256 + cl;
#pragma unroll
                for (int bj = 0; bj < 2; ++bj) *(u32x4*)(rp + bj * HALF) = pack8(acc[ai][bj][m][0], acc[ai][bj][m][1]); }
        } else if (pn < 18) {
            PG8_FOR_AI_M { bf16_t* rp = CU + (size_t)(row0 + ai * HALF + m * 16) * 512 + (pn - 14) * 128 + cl;
                *(u32x4*)rp = pack8(acc[ai][0][m][0] * acc[ai][1][m][0], acc[ai][0][m][1] * acc[ai][1][m][1]); }
        } else if (pn < 21) {
            PG8_FOR_AI_M { bf16_t* rp = QL + (size_t)(row0 + ai * HALF + m * 16) * 768 + (pn - 18) * 256 + cl;
#pragma unroll
                for (int bj = 0; bj < 2; ++bj) *(u32x4*)(rp + bj * HALF) = pack8(acc[ai][bj][m][0], acc[ai][bj][m][1]); }
        } else if (pn == 21) {
            PG8_FOR_AI_M { bf16_t* rp = KVL + (size_t)(row0 + ai * HALF + m * 16) * 256 + cl;
#pragma unroll
                for (int bj = 0; bj < 2; ++bj) *(u32x4*)(rp + bj * HALF) = pack8(acc[ai][bj][m][0], acc[ai][bj][m][1]); }
        } else if (pn < 26) {
            PG8_FOR_AI_M { bf16_t* rp = U + (size_t)(row0 + ai * HALF + m * 16) * 512 + (pn - 22) * 128 + cl;
                f32x4 a = acc[ai][0][m][0], b = acc[ai][0][m][1]; const f32x4 ga = acc[ai][1][m][0], gb = acc[ai][1][m][1];
#pragma unroll
                for (int j = 0; j < 4; ++j) { a[j] *= fsigmoid(ga[j]); b[j] *= fsigmoid(gb[j]); }
                *(u32x4*)rp = pack8(a, b); }
        } else {
            if (wc == 0) { PG8_FOR_AI_M { bf16_t* rp = KRR + (size_t)(row0 + ai * HALF + m * 16) * 32 + cl; *(u32x4*)rp = pack8(acc[ai][0][m][0], acc[ai][0][m][1]); } }
        }
    }
};
template <bool FIRST> struct EpiGateRmw {
    static constexpr bool PERM = true;
    bf16_t* SG; int gcol, dcol;
    __device__ __forceinline__ void operator()(const f32x4 (&acc)[2][2][4][2], const Unit& u, int wr, int wc, int fr, int fq) const {
        const int row0 = u.pm * BM + wr * 64 + fr, cl = wc * 32 + 8 * fq;
        PG8_FOR_AI_M { bf16_t* rp = SG + (size_t)(row0 + ai * HALF + m * 16) * 3072 + u.pn * 256 + cl;
#pragma unroll
            for (int bj = 0; bj < 2; ++bj) { const u32x4 gw = *(const u32x4*)(rp + gcol + bj * HALF); f32x4 g0, g1; unpack8(gw, g0, g1);
                f32x4 o0 = g0 * acc[ai][bj][m][0], o1 = g1 * acc[ai][bj][m][1];
                if (!FIRST) { const u32x4 mw = *(const u32x4*)(rp + bj * HALF); f32x4 m0, m1; unpack8(mw, m0, m1); o0 += m0; o1 += m1; }
                *(u32x4*)(rp + dcol + bj * HALF) = pack8(o0, o1); }
            if (m & 1) asm volatile("" ::: "memory"); }
    }
};
struct EpiQ {
    static constexpr bool PERM = false;
    unsigned char* ws;
    __device__ __forceinline__ void operator()(const f32x4 (&acc)[2][2][4][2], const Unit& u, int wr, int wc, int fr, int fq) const {
        const int row0 = u.pm * BM + wr * 64 + fr;
        bf16_t* Q = (bf16_t*)(ws + WS_XN); const float* rstd = (const float*)(ws + WS_SMALL + SM_RSTDQ); const f32x2* cossin = (const f32x2*)(ws + WS_SMALL + SM_COSSIN);
        constexpr float C2 = 0.10206207261596575f * 1.4426950408889634f;
        PG8_FOR_AI_M { const int row = row0 + ai * HALF + m * 16; const float rs = rstd[row] * C2;
#pragma unroll
            for (int bj = 0; bj < 2; ++bj) { const int g32 = 8 * u.pn + 4 * bj + wc; bf16_t* rp = Q + (size_t)row * 768 + 32 * g32 + 4 * fq;
                f32x4 a = acc[ai][bj][m][0] * rs, b = acc[ai][bj][m][1] * rs;
                if (g32 % 3 == 2) { const f32x2* cs = cossin + (size_t)row * 16 + 4 * fq; f32x4 o1, o2;
#pragma unroll
                    for (int j = 0; j < 4; ++j) { const f32x2 c = cs[j]; o1[j] = a[j] * c.x - b[j] * c.y; o2[j] = a[j] * c.y + b[j] * c.x; }
                    a = o1; b = o2; }
                u32x2 w0, w1; w0.x = cvt_pk_bf16(a[0], a[1]); w0.y = cvt_pk_bf16(a[2], a[3]); w1.x = cvt_pk_bf16(b[0], b[1]); w1.y = cvt_pk_bf16(b[2], b[3]);
                *(u32x2*)rp = w0; *(u32x2*)(rp + 16) = w1; }
            if (m & 1) asm volatile("" ::: "memory"); }
    }
};
struct EpiKV {
    static constexpr bool PERM = true;
    unsigned char* ws;
    __device__ __forceinline__ void operator()(const f32x4 (&acc)[2][2][4][2], const Unit& u, int wr, int wc, int fr, int fq) const {
        const int row0 = u.pm * BM + wr * 64 + fr;
        const float* rstd = (const float*)(ws + WS_SMALL + SM_RSTDKV);
        bf16_t* dst = (bf16_t*)(ws + WS_R + ((wc < 2) ? R_SCB : R_CU)); const int cw = (wc & 1) * 32 + 8 * fq;
        PG8_FOR_AI_M { const int row = row0 + ai * HALF + m * 16; const float rs = rstd[row];
#pragma unroll
            for (int bj = 0; bj < 2; ++bj) *(u32x4*)(dst + (size_t)row * 512 + (2 * u.pn + bj) * 64 + cw) = pack8(acc[ai][bj][m][0] * rs, acc[ai][bj][m][1] * rs); }
    }
};
struct EpiResF32 {
    static constexpr bool PERM = false;
    const float* Xin; float* Xout;
    __device__ __forceinline__ void operator()(const f32x4 (&acc)[2][2][4][2], const Unit& u, int wr, int wc, int fr, int fq) const {
        const int row0 = u.pm * BM + wr * 64 + fr, c0 = u.pn * BM + wc * 32 + 4 * fq;
        PG8_FOR_AI_M { const size_t off = (size_t)(row0 + ai * HALF + m * 16) * 1024 + c0;
#pragma unroll
            for (int bj = 0; bj < 2; ++bj)
#pragma unroll
                for (int n = 0; n < 2; ++n) { const f32x4 x = *(const f32x4*)(Xin + off + bj * HALF + n * 16); *(f32x4*)(Xout + off + bj * HALF + n * 16) = x + acc[ai][bj][m][n]; }
            if (m & 1) asm volatile("" ::: "memory"); }
    }
};
struct EpiMoeGU {
    static constexpr bool PERM = true;
    unsigned char* ws;
    __device__ __forceinline__ void operator()(const f32x4 (&acc)[2][2][4][2], const Unit& u, int wr, int wc, int fr, int fq) const {
        const int row0 = u.pm * BM + wr * 64 + fr, cl = (u.pn & 1) * 128 + wc * 32 + 8 * fq;
        bf16_t* H = (bf16_t*)(ws + WS_R + R_H); const float* roww = (const float*)(ws + WS_SMALL + SM_ROWW);
        PG8_FOR_AI_M { const int row = row0 + ai * HALF + m * 16; const float rw = roww[row];
            f32x4 a = acc[ai][0][m][0], b = acc[ai][0][m][1]; const f32x4 ua = acc[ai][1][m][0], ub = acc[ai][1][m][1];
#pragma unroll
            for (int j = 0; j < 4; ++j) { a[j] = a[j] * fsigmoid(a[j]) * ua[j] * rw; b[j] = b[j] * fsigmoid(b[j]) * ub[j] * rw; }
            *(u32x4*)(H + (size_t)row * 256 + cl) = pack8(a, b); }
    }
};
struct EpiStoreBf16 {
    static constexpr bool PERM = true;
    bf16_t* O; int ldc, cmask;
    __device__ __forceinline__ void operator()(const f32x4 (&acc)[2][2][4][2], const Unit& u, int wr, int wc, int fr, int fq) const {
        const int row0 = u.pm * BM + wr * 64 + fr, cl = (u.pn & cmask) * 256 + wc * 32 + 8 * fq;
        PG8_FOR_AI_M { bf16_t* rp = O + (size_t)(row0 + ai * HALF + m * 16) * ldc + cl;
#pragma unroll
            for (int bj = 0; bj < 2; ++bj) *(u32x4*)(rp + bj * HALF) = pack8(acc[ai][bj][m][0], acc[ai][bj][m][1]); }
    }
};
struct EpiPle {
    static constexpr bool PERM = false;
    float* X; unsigned char* ws; float* Xo;
    __device__ __forceinline__ void operator()(const f32x4 (&acc)[2][2][4][2], const Unit& u, int wr, int wc, int fr, int fq) const {
        const int row0 = u.pm * BM + wr * 64 + fr, c0 = u.pn * BM + wc * 32 + 4 * fq;
        const bf16_t* PE = (const bf16_t*)(ws + WS_R + R_XG);
        PG8_FOR_AI_M { const size_t off = (size_t)(row0 + ai * HALF + m * 16) * 1024 + c0;
#pragma unroll
            for (int bj = 0; bj < 2; ++bj)
#pragma unroll
                for (int n = 0; n < 2; ++n) { const size_t o = off + bj * HALF + n * 16; const u32x2 pw = *(const u32x2*)(PE + o); const f32x4 x = *(const f32x4*)(X + o); const f32x4 a = acc[ai][bj][m][n];
                    f32x4 r; r[0] = x[0] + fsigmoid(a[0]) * bf_lo(pw.x); r[1] = x[1] + fsigmoid(a[1]) * bf_hi(pw.x); r[2] = x[2] + fsigmoid(a[2]) * bf_lo(pw.y); r[3] = x[3] + fsigmoid(a[3]) * bf_hi(pw.y);
                    *(f32x4*)(Xo + o) = r; }
            if (m & 1) asm volatile("" ::: "memory"); }
    }
};

template <class Epi, class Sched, bool ALIGN_EPI = true>
__device__ __forceinline__ void gemm_phase(PG8_LAS unsigned char* lds, const Gemm g, const Sched& S, const Epi& E) {
    int tid = threadIdx.x; asm volatile("" : "+v"(tid));
    const int wid = __builtin_amdgcn_readfirstlane(tid >> 6), lane = tid & 63, wr = wid >> 2, wc = wid & 3, fr = lane & 15, fq = lane >> 4;
    const int K = g.K, nt = K / BK;
    unsigned voffA[2], voffB[2];
#pragma unroll
    for (int i = 0; i < 2; ++i) { int R, C; stage_rc(tid * 16 + i * 8192, R, C); const int Rb = Epi::PERM ? ((R & ~31) + perm32(R & 31)) : R;
        voffA[i] = (unsigned)(R * g.lda + C) * 2u; voffB[i] = (unsigned)(Rb * g.ldb + C) * 2u; }
    constexpr unsigned kstep = BK * 2;
    const unsigned hstepA = (unsigned)HALF * g.lda * 2, hstepB = (unsigned)HALF * g.ldb * 2;
    const unsigned tstepA = 2 * hstepA, tstepB = 2 * hstepB;
    const char* const Ab = (const char*)g.A; const char* const Bb = (const char*)g.Bt;
    const unsigned ldsw = (unsigned)wid * 1024u;
    const int aoff = lds_byte(wr * 64 + fr, fq * 8), boff = lds_byte(wc * 32 + fr, fq * 8);
#define PG8_SA(b, h) (((b) * 2 + (h)) * HTB)
#define PG8_SB(b, h) ((4 + (b) * 2 + (h)) * HTB)
#define PG8_STAGE(bufoff, gbase, voff) do { const char* _gb = (const char*)(gbase); asm volatile("" : "+s"(_gb));     \
        _Pragma("unroll") for (int _i = 0; _i < 2; ++_i) \
        __builtin_amdgcn_global_load_lds((const unsigned*)(_gb + (voff)[_i]), (PG8_LAS unsigned*)(lds + (bufoff) + ldsw + _i * 8192), 16, 0, 0); } while (0)
#define PG8_LDA(dst, b, h) do { _Pragma("unroll") for (int m = 0; m < 4; ++m) _Pragma("unroll") for (int k = 0; k < 2; ++k) dst[m][k] = *(const PG8_LAS bf16x8*)(lds + PG8_SA(b, h) + aoff + m * 2048 + k * 1024); } while (0)
#define PG8_LDB(dst, b, h) do { _Pragma("unroll") for (int n = 0; n < 2; ++n) _Pragma("unroll") for (int k = 0; k < 2; ++k) dst[n][k] = *(const PG8_LAS bf16x8*)(lds + PG8_SB(b, h) + boff + n * 2048 + k * 1024); } while (0)
#define PG8_MMA(ai, bj, At, Bt) do { __builtin_amdgcn_s_setprio(1); _Pragma("unroll") for (int m = 0; m < 4; ++m) _Pragma("unroll") for (int n = 0; n < 2; ++n) _Pragma("unroll") for (int k = 0; k < 2; ++k) \
        acc[ai][bj][m][n] = __builtin_amdgcn_mfma_f32_16x16x32_bf16(Bt[n][k], At[m][k], acc[ai][bj][m][n], 0, 0, 0); __builtin_amdgcn_s_setprio(0); } while (0)
#define PG8_WAIT_V(n) asm volatile("s_waitcnt vmcnt(" #n ")" ::: "memory")
#define PG8_WAIT_L(n) asm volatile("s_waitcnt lgkmcnt(" #n ")" ::: "memory")
#define PG8_BAR __builtin_amdgcn_s_barrier()
#define PG8_SCHED __builtin_amdgcn_sched_barrier(0)
    Unit cur, nxt; int ui = 0;
    if (!S.next(0, cur)) return;
    f32x4 acc[2][2][4][2];
#pragma unroll
    for (int a = 0; a < 2; ++a)
#pragma unroll
        for (int b = 0; b < 2; ++b)
#pragma unroll
            for (int m = 0; m < 4; ++m)
#pragma unroll
                for (int n = 0; n < 2; ++n) acc[a][b][m][n] = (f32x4){0.f, 0.f, 0.f, 0.f};
    bf16x8 At[4][2], B0[2][2], B1[2][2];
    unsigned cA = (unsigned)cur.pm * tstepA, cB = (unsigned)cur.pn * tstepB;
    PG8_STAGE(PG8_SB(0, 0), Bb + cB, voffB); PG8_STAGE(PG8_SB(0, 1), Bb + (cB + hstepB), voffB); PG8_STAGE(PG8_SA(0, 0), Ab + cA, voffA); PG8_STAGE(PG8_SA(0, 1), Ab + (cA + hstepA), voffA);
    if (wr == 1) PG8_BAR;
    PG8_WAIT_V(2); PG8_BAR;
    PG8_STAGE(PG8_SB(1, 0), Bb + (cB + kstep), voffB); PG8_STAGE(PG8_SA(1, 0), Ab + (cA + kstep), voffA); PG8_STAGE(PG8_SB(1, 1), Bb + (cB + hstepB + kstep), voffB);
    PG8_WAIT_V(6); PG8_BAR;
    for (;;) {
        const bool has_next = S.next(ui + 1, nxt);
        const unsigned nA = has_next ? (unsigned)nxt.pm * tstepA : cA; const unsigned nB = has_next ? (unsigned)nxt.pn * tstepB : cB;
#pragma unroll 1
        for (int t = 0; t < nt; t += 2) {
            const bool last = (t == nt - 2);
            const char* a1 = Ab + (cA + (unsigned)(t + 1) * kstep);
            const unsigned a2o = last ? nA : cA + (unsigned)(t + 2) * kstep, b2o = last ? nB : cB + (unsigned)(t + 2) * kstep;
            const char* a2 = Ab + a2o; const char* b2 = Bb + b2o;
            const char* a3 = a2 + kstep; const char* b3 = b2 + kstep;
            PG8_LDB(B0, 0, 0); PG8_LDB(B1, 0, 1); PG8_SCHED; PG8_LDA(At, 0, 0); PG8_STAGE(PG8_SA(1, 1), a1 + hstepA, voffA);
            PG8_WAIT_V(8); PG8_WAIT_L(0); PG8_BAR; PG8_MMA(0, 0, At, B0); PG8_MMA(0, 1, At, B1); PG8_BAR; PG8_SCHED;
            PG8_LDA(At, 0, 1); PG8_STAGE(PG8_SB(0, 0), b2, voffB); PG8_STAGE(PG8_SB(0, 1), b2 + hstepB, voffB); PG8_STAGE(PG8_SA(0, 0), a2, voffA);
            PG8_WAIT_V(8); PG8_WAIT_L(0); PG8_BAR; PG8_MMA(1, 0, At, B0); PG8_MMA(1, 1, At, B1); PG8_BAR; PG8_SCHED;
            PG8_LDB(B0, 1, 0); PG8_LDB(B1, 1, 1); PG8_SCHED; PG8_LDA(At, 1, 0); PG8_STAGE(PG8_SA(0, 1), a2 + hstepA, voffA);
            PG8_WAIT_V(8); PG8_WAIT_L(0); PG8_BAR; PG8_MMA(0, 0, At, B0); PG8_MMA(0, 1, At, B1); PG8_BAR; PG8_SCHED;
            PG8_LDA(At, 1, 1); PG8_STAGE(PG8_SB(1, 0), b3, voffB); PG8_STAGE(PG8_SB(1, 1), b3 + hstepB, voffB); PG8_STAGE(PG8_SA(1, 0), a3, voffA);
            PG8_WAIT_V(8); PG8_WAIT_L(0); PG8_BAR; PG8_MMA(1, 0, At, B0); PG8_MMA(1, 1, At, B1); PG8_BAR; PG8_SCHED;
        }
        if constexpr (ALIGN_EPI) { if (wr == 0) PG8_BAR; }
        E(acc, cur, wr, wc, fr, fq);
        if (!has_next) break;
#pragma unroll
        for (int a = 0; a < 2; ++a)
#pragma unroll
            for (int b = 0; b < 2; ++b)
#pragma unroll
                for (int m = 0; m < 4; ++m)
#pragma unroll
                    for (int n = 0; n < 2; ++n) acc[a][b][m][n] = (f32x4){0.f, 0.f, 0.f, 0.f};
        cur = nxt; cA = nA; cB = nB; ++ui;
        if constexpr (ALIGN_EPI) { if (wr == 1) PG8_BAR; }
    }
    PG8_WAIT_V(0);
    if constexpr (!ALIGN_EPI) { if (wr == 0) PG8_BAR; }
    PG8_BAR;
#undef PG8_SA
#undef PG8_SB
#undef PG8_STAGE
#undef PG8_LDA
#undef PG8_LDB
#undef PG8_MMA
#undef PG8_WAIT_V
#undef PG8_WAIT_L
#undef PG8_BAR
#undef PG8_SCHED
}
}
using pg8::cvt_pk_bf16; using pg8::bf_lo; using pg8::bf_hi; using pg8::fsigmoid;
namespace attn {
using bf16x8 = __attribute__((ext_vector_type(8))) short;
using s16x4 = __attribute__((ext_vector_type(4))) short;
using f32x16 = __attribute__((ext_vector_type(16))) float;
using u32x4 = __attribute__((ext_vector_type(4))) unsigned;
typedef LAS char* lptr;
typedef const LAS char* lcptr;
constexpr int KSLOT = 12288, VSLOT = 8192;
constexpr int LDS_K = 0, LDS_V = 2 * KSLOT, LDS_WS = LDS_V + 2 * VSLOT, LDS_OST = LDS_WS + 8 * 256, LDS_BYTES = LDS_OST + 8 * 4096;
__device__ __forceinline__ int crow(int r, int hi) { return (r & 3) + 8 * (r >> 2) + 4 * hi; }
__device__ __forceinline__ void glds16(const void* gsrc, unsigned lds_dst) { unsigned keep;
    asm volatile("s_mov_b32 %0, m0\n\ts_mov_b32 m0, %2\n\ts_nop 0\n\tglobal_load_lds_dwordx4 %1, off\n\ts_mov_b32 m0, %0" : "=&s"(keep) : "v"(gsrc), "s"(lds_dst) : "memory"); }
__device__ __forceinline__ unsigned cvtpk_s(float lo, float hi) { return cvt_pk_bf16(lo, hi); }
__device__ __forceinline__ void cmask(f32x16& p0, f32x16& p1, int jb, int qrel, int hi) {
    const float NEG = -INFINITY; const int kb = 64 * jb + 4 * hi;
#pragma unroll
    for (int r = 0; r < 16; ++r) { const int kv = kb + (r & 3) + 8 * (r >> 2); if (kv > qrel) p0[r] = NEG; if (kv + 32 > qrel) p1[r] = NEG; }
}
__device__ __forceinline__ void qkt6(f32x16& p0, f32x16& p1, lcptr kb, const bf16x8* qr) {
    f32x16 z = {};
#pragma unroll
    for (int d0 = 0; d0 < 6; ++d0) {
        const bf16x8 b0 = *(const LAS bf16x8*)(kb + d0 * 2048);
        const bf16x8 b1 = *(const LAS bf16x8*)(kb + d0 * 2048 + 512);
        if (d0 == 0) { p0 = __builtin_amdgcn_mfma_f32_32x32x16_bf16(b0, qr[0], z, 0, 0, 0); p1 = __builtin_amdgcn_mfma_f32_32x32x16_bf16(b1, qr[0], z, 0, 0, 0); }
        else { p0 = __builtin_amdgcn_mfma_f32_32x32x16_bf16(b0, qr[d0], p0, 0, 0, 0); p1 = __builtin_amdgcn_mfma_f32_32x32x16_bf16(b1, qr[d0], p1, 0, 0, 0); }
    }
}
__device__ __forceinline__ float rowmax(const f32x16& p0, const f32x16& p1) {
    float a = fmaxf(p0[0], p1[0]);
#pragma unroll
    for (int r = 1; r < 16; ++r) a = fmaxf(a, fmaxf(p0[r], p1[r]));
    auto rr = __builtin_amdgcn_permlane32_swap(__float_as_uint(a), __float_as_uint(a), false, false);
    return fmaxf(__uint_as_float(rr[0]), __uint_as_float(rr[1]));
}
__device__ __forceinline__ void pv(f32x16* o, int vb, bf16x8 pa0, bf16x8 pa1, bf16x8 pa2, bf16x8 pa3) {
#pragma unroll
    for (int d0 = 0; d0 < 2; ++d0) { s16x4 lo[4], hi[4];
#pragma unroll
        for (int ks = 0; ks < 4; ++ks) {
            asm volatile("ds_read_b64_tr_b16 %0,%1 offset:%c2" : "=&v"(lo[ks]) : "v"(vb), "i"(d0 * 4096 + ks * 1024) : "memory");
            asm volatile("ds_read_b64_tr_b16 %0,%1 offset:%c2" : "=&v"(hi[ks]) : "v"(vb), "i"(d0 * 4096 + ks * 1024 + 512) : "memory"); }
        asm volatile("s_waitcnt lgkmcnt(0)" ::: "memory"); __builtin_amdgcn_sched_barrier(0);
#define ATT_PK(k) (bf16x8){lo[k][0], lo[k][1], lo[k][2], lo[k][3], hi[k][0], hi[k][1], hi[k][2], hi[k][3]}
        o[d0] = __builtin_amdgcn_mfma_f32_32x32x16_bf16(pa0, ATT_PK(0), o[d0], 0, 0, 0);
        o[d0] = __builtin_amdgcn_mfma_f32_32x32x16_bf16(pa1, ATT_PK(1), o[d0], 0, 0, 0);
        o[d0] = __builtin_amdgcn_mfma_f32_32x32x16_bf16(pa2, ATT_PK(2), o[d0], 0, 0, 0);
        o[d0] = __builtin_amdgcn_mfma_f32_32x32x16_bf16(pa3, ATT_PK(3), o[d0], 0, 0, 0);
#undef ATT_PK
    }
}
__device__ __forceinline__ void attn_unit(int b, int h, int qb, const bf16* Q, const bf16* Kn, const bf16* Kr, const bf16* V, bf16* O, lptr shm) {
    int tid = threadIdx.x; asm volatile("" : "+v"(tid));
    const int lane = tid & 63, r32 = lane & 31, hi = lane >> 5; const int wid = __builtin_amdgcn_readfirstlane(tid >> 6);
    const long rowbase = (long)b * S; const int q0 = qb * 256;
    const bf16* Qw = Q + (rowbase + q0 + wid * 32) * 768 + h * 96;
    const unsigned lds0 = (unsigned)(size_t)shm;
    LAS float* wsf = (LAS float*)(shm + LDS_WS) + wid * 64;
    const bf16* ksrc = Kn + (rowbase + lane) * 512 + h * 64 + wid * 8;
    const bf16* krsrc = Kr + (rowbase + lane) * 32 + (wid & 3) * 8;
    const bf16* vsrc = V + (rowbase + 16 * (wid & 3) + (lane >> 2)) * 512 + h * 64 + (wid >> 2) * 32 + (lane & 3) * 8;
    const unsigned kdst = lds0 + LDS_K + wid * 1024, krdst = lds0 + LDS_K + (8 + (wid & 3)) * 1024, vdst = lds0 + LDS_V + wid * 1024;
#define ATT_DMA_K(t, so) do { glds16(ksrc + (long)(t) * 64 * 512, (unsigned)__builtin_amdgcn_readfirstlane(kdst + (so))); \
        if (wid < 4) glds16(krsrc + (long)(t) * 64 * 32, (unsigned)__builtin_amdgcn_readfirstlane(krdst + (so))); } while (0)
#define ATT_DMA_V(t, so) glds16(vsrc + (long)(t) * 64 * 512, (unsigned)__builtin_amdgcn_readfirstlane(vdst + (so)))
    const int vb0 = (int)(lds0 + LDS_V) + ((lane >> 4) & 1) * 32 + (lane & 3) * 8 + (4 * hi + ((lane & 15) >> 2)) * 64;
    const lcptr kp0 = (lcptr)shm + LDS_K + hi * 1024 + r32 * 16;
    const int NT = (q0 + 256) / 64;
    ATT_DMA_K(0, 0); ATT_DMA_V(0, 0);
    bf16x8 qr[6];
#pragma unroll
    for (int d0 = 0; d0 < 6; ++d0) qr[d0] = *reinterpret_cast<const bf16x8*>(&Qw[(long)r32 * 768 + d0 * 16 + hi * 8]);
    float m_run = -1e30f, l_run = 0.f; f32x16 o[2]; o[0] = f32x16{}; o[1] = f32x16{};
    const int qrel = wid * 32 + r32;
    asm volatile("s_waitcnt vmcnt(0) lgkmcnt(0)\n\ts_barrier" ::: "memory");
    for (int t = 0; t < NT; ++t) {
        const int cur = t & 1;
        if (t + 1 < NT) { ATT_DMA_K(t + 1, (cur ^ 1) * KSLOT); ATT_DMA_V(t + 1, (cur ^ 1) * VSLOT); }
        f32x16 p0, p1;
        qkt6(p0, p1, kp0 + cur * KSLOT, qr);
        const int jb = t - (NT - 4);
        if (jb >= 0) cmask(p0, p1, jb, qrel, hi);
        const float rm = rowmax(p0, p1);
        const float m_new = fmaxf(m_run, rm);
        const float alpha = __builtin_amdgcn_exp2f(m_run - m_new);
        m_run = m_new;
        float sacc = 0.f;
#pragma unroll
        for (int r = 0; r < 16; ++r) { p0[r] = __builtin_amdgcn_exp2f(p0[r] - m_new); p1[r] = __builtin_amdgcn_exp2f(p1[r] - m_new); sacc += p0[r] + p1[r]; }
        l_run = l_run * alpha + sacc;
        if (__any(alpha != 1.0f)) {
            if (hi == 0) wsf[r32] = alpha;
            asm volatile("s_waitcnt lgkmcnt(0)" ::: "memory");
#pragma unroll
            for (int r = 0; r < 16; ++r) { const float f = wsf[crow(r, hi)]; o[0][r] *= f; o[1][r] *= f; }
        }
        u32x4 pw0, pw1, pw2, pw3;
#define ATT_PKW(P, B) cvtpk_s(P[B], P[B + 1])
        pw0 = (u32x4){ATT_PKW(p0, 0), ATT_PKW(p0, 2), ATT_PKW(p0, 4), ATT_PKW(p0, 6)}; pw1 = (u32x4){ATT_PKW(p0, 8), ATT_PKW(p0, 10), ATT_PKW(p0, 12), ATT_PKW(p0, 14)};
        pw2 = (u32x4){ATT_PKW(p1, 0), ATT_PKW(p1, 2), ATT_PKW(p1, 4), ATT_PKW(p1, 6)}; pw3 = (u32x4){ATT_PKW(p1, 8), ATT_PKW(p1, 10), ATT_PKW(p1, 12), ATT_PKW(p1, 14)};
#undef ATT_PKW
        pv(o, vb0 + cur * VSLOT, __builtin_bit_cast(bf16x8, pw0), __builtin_bit_cast(bf16x8, pw1), __builtin_bit_cast(bf16x8, pw2), __builtin_bit_cast(bf16x8, pw3));
        asm volatile("s_waitcnt vmcnt(0) lgkmcnt(0)\n\ts_barrier" ::: "memory");
    }
    { auto rr = __builtin_amdgcn_permlane32_swap(__float_as_uint(l_run), __float_as_uint(l_run), false, false); l_run = __uint_as_float(rr[0]) + __uint_as_float(rr[1]); }
    if (hi == 0) wsf[32 + r32] = l_run;
    asm volatile("s_waitcnt lgkmcnt(0)" ::: "memory");
    float rli[16];
#pragma unroll
    for (int r = 0; r < 16; ++r) rli[r] = __builtin_amdgcn_rcpf(wsf[32 + crow(r, hi)]);
    bf16* Ow = O + (rowbase + q0 + wid * 32) * 512 + h * 64;
    { LAS bf16* stg = (LAS bf16*)(shm + LDS_OST) + wid * 2048;
#pragma unroll
        for (int r = 0; r < 16; ++r) { const int orow = crow(r, hi);
#pragma unroll
            for (int d0 = 0; d0 < 2; ++d0) stg[orow * 64 + d0 * 32 + r32] = (bf16)(cvt_pk_bf16(o[d0][r] * rli[r], 0.f) & 0xffffu); }
        asm volatile("s_waitcnt lgkmcnt(0)" ::: "memory");
#pragma unroll
        for (int i = 0; i < 4; ++i) { const int row = i * 8 + (lane >> 3), ch = lane & 7; const u32x4 v = *(const LAS u32x4*)(stg + row * 64 + ch * 8); *(u32x4*)(Ow + (long)row * 512 + ch * 8) = v; } }
    asm volatile("s_waitcnt lgkmcnt(0)\n\ts_barrier" ::: "memory");
#undef ATT_DMA_K
#undef ATT_DMA_V
}
}

static_assert(attn::LDS_BYTES <= RING_BYTES, "attention LDS");
#define LDS_WAIT() asm volatile("s_waitcnt lgkmcnt(0)" ::: "memory")
#define VM_WAIT() asm volatile("s_waitcnt vmcnt(0)" ::: "memory")

#define XB_TMO      128
#define XB_XCNT(j)  (256  + 64 * (j))
#define XB_XSUB(j)  (1280 + 64 * (j))
#define XB_XGEN(j)  (2304 + 64 * (j))
#define XB_TOP      3328
#define XB_TOPGEN   3392
#define XCD_BAR_WORDS 3456
#define XB_SPIN_CAP (1u << 18)
__device__ __forceinline__ unsigned xb_ld(unsigned* p)              { return __hip_atomic_load(p, __ATOMIC_RELAXED, __HIP_MEMORY_SCOPE_AGENT); }
__device__ __forceinline__ unsigned xb_add(unsigned* p, unsigned v) { return __hip_atomic_fetch_add(p, v, __ATOMIC_RELAXED, __HIP_MEMORY_SCOPE_AGENT); }
__device__ __forceinline__ unsigned xb_xcc_id() { return (unsigned)__builtin_amdgcn_s_getreg((3 << 11) | 20) & 0xFu; }
#define XB_SPIN(cond, bar) do { unsigned _sp = 0; while (cond) { __builtin_amdgcn_s_sleep(1); \
    if ((++_sp & 255u) == 0u) { if (xb_ld(&(bar)[XB_TMO])) break; if (_sp > XB_SPIN_CAP) { atomicAdd(&(bar)[XB_TMO], 1u); break; } } } } while (0)
struct XcdBarrier { unsigned* bar; unsigned x; volatile LAS unsigned* st; };
__device__ __forceinline__ XcdBarrier xcd_barrier_post(unsigned* bar, volatile LAS unsigned* st) {
    XcdBarrier b; b.bar = bar; b.x = xb_xcc_id(); b.st = st;
    if (threadIdx.x == 0) (void)xb_add(&bar[XB_XCNT(b.x)], 1u);
    return b;
}
__device__ __forceinline__ void xcd_barrier_complete(unsigned* bar, unsigned x, unsigned& nloc, unsigned& nx) {
    const unsigned G = gridDim.x * gridDim.y * gridDim.z;
    unsigned sum, cnt, mine, sp = 0u;
    for (;;) {
        sum = 0u; cnt = 0u; mine = 0u;
#pragma unroll 1
        for (unsigned j = 0; j < 16; ++j) { const unsigned c = xb_ld(&bar[XB_XCNT(j)]); sum += c; cnt += (c > 0u) ? 1u : 0u; mine = (j == x) ? c : mine; }
        if (sum == G) break;
        __builtin_amdgcn_s_sleep(1);
        if ((++sp & 255u) == 0u) { if (xb_ld(&bar[XB_TMO])) break; if (sp > XB_SPIN_CAP) { atomicAdd(&bar[XB_TMO], 1u); break; } }
    }
    nloc = mine > 0u ? mine : 1u; nx = cnt > 0u ? cnt : 1u;
}
__device__ __forceinline__ void xcd_barrier(const XcdBarrier& b) {
    asm volatile("s_waitcnt vmcnt(0)" ::: "memory");
    __syncthreads();
    if (threadIdx.x == 0) {
        unsigned* bar = b.bar;
        __builtin_amdgcn_s_waitcnt(0);
        unsigned nloc = b.st[0], nx = b.st[1];
        const unsigned bx_ = xb_xcc_id();
        if (nloc == 0u) { xcd_barrier_complete(bar, bx_, nloc, nx); b.st[0] = nloc; b.st[1] = nx; }
        const unsigned old = xb_add(&bar[XB_XSUB(bx_)], 1u);
        const unsigned gen = old / nloc;
        if (old + 1u == (gen + 1u) * nloc) {
            __builtin_amdgcn_fence(__ATOMIC_RELEASE, "agent");
            asm volatile("s_waitcnt vmcnt(0)" ::: "memory");
            const unsigned og = xb_add(&bar[XB_TOP], 1u);
            const unsigned tg = og / nx;
            if (og + 1u == (tg + 1u) * nx) xb_add(&bar[XB_TOPGEN], 1u);
            else XB_SPIN(xb_ld(&bar[XB_TOPGEN]) == tg, bar);
            __builtin_amdgcn_fence(__ATOMIC_ACQUIRE, "agent");
            xb_add(&bar[XB_XGEN(bx_)], 1u);
            asm volatile("s_waitcnt vmcnt(0)" ::: "memory");
        } else {
            XB_SPIN(xb_ld(&bar[XB_XGEN(bx_)]) == gen, bar);
            __builtin_amdgcn_fence(__ATOMIC_ACQUIRE, "agent");
            asm volatile("s_waitcnt vmcnt(0)" ::: "memory");
        }
    }
    __syncthreads();
}

struct Args { const void* in[29]; float* out; unsigned char* ws; int ph_lo, ph_hi, l_lo, l_hi, li, do_final; };
__device__ __forceinline__ float wave_sum(float v) {
#pragma unroll
    for (int o = 1; o < 64; o <<= 1) v += __shfl_xor(v, o);
    return v;
}
__device__ __forceinline__ unsigned pk2(float lo, float hi) { return cvt_pk_bf16(lo, hi); }

__device__ __forceinline__ int w_row_map(int kind, int row_off, int n0) {
    if (kind == 0) return row_off + n0;
    if (kind == 1) {
        if (n0 < 3584) return n0;
        if (n0 < 4096) { const int j = (n0 - 3584) >> 7, r = (n0 - 3584) & 127; return 3584 + 256 * j + r; }
        if (n0 < 4608) { const int j = (n0 - 4096) >> 7, r = (n0 - 4096) & 127; return 3584 + 256 * j + 128 + r; }
        if (n0 < 5632) return n0;
        if (n0 < 5664) return 6656 + (n0 - 5632);
        if (n0 < 6176) { const int j = (n0 - 5664) >> 7, r = (n0 - 5664) & 127; return 5632 + 256 * j + r; }
        { const int j = (n0 - 6176) >> 7, r = (n0 - 6176) & 127; return 5632 + 256 * j + 128 + r; }
    }
    const int j = n0 >> 7, r = n0 & 127;
    return row_off + 256 * j + (kind == 3 ? 128 : 0) + r;
}
__device__ __forceinline__ void w_transpose_item(const float* W, int K, int N, bf16* WT, int kind, int row_off, const float* gain, LAS unsigned* scr, int item, int lane) {
    const int nblk = (N + 63) >> 6, kb = item / nblk, nb = item - kb * nblk, k0 = 64 * kb, n0 = 64 * nb;
    const int nq = lane & 15, kr = lane >> 4; const bool nok = (n0 + 4 * nq) < N;
    const float* src = W + (size_t)(k0 + 2 * kr) * N + n0 + 4 * nq;
#pragma unroll
    for (int i = 0; i < 8; ++i) {
        f32x4 a = (f32x4){0.f, 0.f, 0.f, 0.f}, b = a;
        if (nok) { a = *(const f32x4*)(src + (size_t)(8 * i) * N); b = *(const f32x4*)(src + (size_t)(8 * i + 1) * N); }
        if (gain) { const float ga = gain[k0 + 8 * i + 2 * kr], gb = gain[k0 + 8 * i + 2 * kr + 1]; a = a * ga; b = b * gb; }
        LAS unsigned* d = scr + (4 * i + kr) * 66 + 4 * nq;
        *(LAS v2u*)d = (v2u){pk2(a[0], b[0]), pk2(a[1], b[1])}; *(LAS v2u*)(d + 2) = (v2u){pk2(a[2], b[2]), pk2(a[3], b[3])};
    }
    LDS_WAIT(); asm volatile("" ::: "memory");
    const int rr = lane >> 3, c = lane & 7; const int d0 = w_row_map(kind, row_off, n0), d1 = (n0 + 32 < N) ? w_row_map(kind, row_off, n0 + 32) : 0;
#pragma unroll
    for (int j = 0; j < 8; ++j) { const int n = rr + 8 * j; const LAS unsigned* s = scr + (4 * c) * 66 + n;
        v4u o; o.x = s[0]; o.y = s[66]; o.z = s[132]; o.w = s[198];
        if (n0 + n < N) { const int drow = (n < 32) ? d0 + n : d1 + (n - 32); *(v4u*)(WT + (size_t)drow * K + k0 + 8 * c) = o; } }
    LDS_WAIT(); asm volatile("" ::: "memory");
}
typedef const __attribute__((address_space(4))) unsigned char* kaptr;
__device__ __forceinline__ kaptr ka_get() { kaptr p = (kaptr)__builtin_amdgcn_kernarg_segment_ptr(); asm volatile("" : "+s"(p)); return p; }
__device__ __forceinline__ const float* ka_in(kaptr ka, int idx) { return (const float*)(const GAS float*)(*(const __attribute__((address_space(4))) unsigned long long*)(ka + 8 * idx)); }
__device__ __forceinline__ float* ka_out(kaptr ka) { return (float*)(GAS float*)(*(const __attribute__((address_space(4))) unsigned long long*)(ka + 8 * 29)); }
__device__ __forceinline__ unsigned char* ka_ws(kaptr ka) { return (unsigned char*)(GAS unsigned char*)(*(const __attribute__((address_space(4))) unsigned long long*)(ka + 8 * 30)); }
__device__ __forceinline__ int ka_int(kaptr ka, int i) { return *(const __attribute__((address_space(4))) int*)(ka + 248 + 4 * i); }
__device__ __forceinline__ int get_bx() { int bx = blockIdx.x; asm volatile("" : "+s"(bx)); return bx; }
__device__ __forceinline__ int get_G() { int G = gridDim.x; asm volatile("" : "+s"(G)); return G; }
__device__ __forceinline__ int get_vcu() { const int G = get_G(), bx = get_bx(); return (G % 8 == 0) ? (bx % 8) * (G / 8) + bx / 8 : bx; }
struct Tid { int tid, lane, wave; };
__device__ __forceinline__ Tid get_tid() { Tid t; t.tid = threadIdx.x; asm volatile("" : "+v"(t.tid)); t.lane = t.tid & 63; t.wave = __builtin_amdgcn_readfirstlane(t.tid >> 6); return t; }

#define KIN(idx, stride) (ka_in(ka, (idx)) + (size_t)L * (stride))

__device__ __forceinline__ void phase_w(kaptr ka, int L, LAS unsigned char* lds) {
    const Tid T = get_tid(); const int vcu = get_vcu(), G = get_G();
    unsigned char* ws = ka_ws(ka); unsigned char* wb = ws + WS_W;
    LAS unsigned* scr = (LAS unsigned*)(lds + T.wave * 16384);
    const int gw = vcu * NWAVES + T.wave, NGW = G * NWAVES;
    constexpr int I_IN = 16 * ((INC + 63) / 64), I_OX = 8 * 16, I_UQ = 12 * 12, I_UKV = 4 * 16, I_O = 16 * 16, I_EG = 32 * 64, I_ED = 32 * 64, I_PG = 16 * 16, I_PLE = 4 * 16;
    constexpr int NITEMS = I_IN + 3 * I_OX + I_UQ + I_UKV + I_O + 2 * I_EG + I_ED + I_PG + I_PLE;
    for (int it = gw; it < NITEMS; it += NGW) {
        int r = it; const float* src; int K, N, kind = 0, roff = 0; size_t dsto; const float* gain = nullptr;
        if (r < I_IN) { src = KIN(4, (size_t)D * INC); K = 1024; N = INC; dsto = WO_IN; kind = 1; gain = KIN(3, D); }
        else if ((r -= I_IN) < I_OX) { src = KIN(6, 512 * D); K = 512; N = 1024; dsto = WO_OUTA; }
        else if ((r -= I_OX) < I_OX) { src = KIN(15, 512 * D); K = 512; N = 1024; dsto = WO_OUTC; }
        else if ((r -= I_OX) < I_OX) { src = KIN(11, 512 * D); K = 512; N = 1024; dsto = WO_OUTB; }
        else if ((r -= I_OX) < I_UQ) { src = KIN(8, 768 * 768); K = 768; N = 768; dsto = WO_UQ; gain = KIN(7, 768); }
        else if ((r -= I_UQ) < I_UKV) { src = KIN(10, 256 * 1024); K = 256; N = 1024; dsto = WO_UKV; gain = KIN(9, 256); }
        else if ((r -= I_UKV) < I_O) { src = KIN(16, D * D); K = 1024; N = 1024; dsto = WO_O; }
        else if ((r -= I_O) < I_EG) { const int e = r >> 6; r &= 63; src = KIN(22, (size_t)32 * D * 256) + (size_t)e * D * 256; K = 1024; N = 256; dsto = WO_GU; kind = 2; roff = e * 512; gain = KIN(17, D); }
        else if ((r -= I_EG) < I_EG) { const int e = r >> 6; r &= 63; src = KIN(23, (size_t)32 * D * 256) + (size_t)e * D * 256; K = 1024; N = 256; dsto = WO_GU; kind = 3; roff = e * 512; gain = KIN(17, D); }
        else if ((r -= I_EG) < I_ED) { const int e = r >> 6; r &= 63; src = KIN(24, (size_t)32 * 256 * D) + (size_t)e * 256 * D; K = 256; N = 1024; dsto = WO_DN; roff = e * 1024; }
        else if ((r -= I_ED) < I_PG) { src = KIN(26, D * D); K = 1024; N = 1024; dsto = WO_PG; gain = KIN(25, D); }
        else { r -= I_PG; src = KIN(27, 256 * D); K = 256; N = 1024; dsto = WO_PLE; }
        w_transpose_item(src, K, N, (bf16*)(wb + dsto), kind, roff, gain, scr, r, T.lane);
    }
    const int gt = vcu * 512 + T.tid, NGT = G * 512;
    { bf16* WRh = (bf16*)(wb + WO_WR); bf16* WRl = WRh + 48 * 1024; const float* g = KIN(17, D); const float* wrg = KIN(18, D * 4); const float* wre = KIN(20, D * 32);
      for (int i = gt; i < 48 * 1024; i += NGT) { const int c = i >> 10, k = i & 1023; const float v = c < 36 ? g[k] * (c < 4 ? wrg[k * 4 + c] : wre[k * 32 + (c - 4)]) : 0.f;
        const unsigned h = pk2(v, 0.f) & 0xffffu; WRh[i] = (bf16)h; WRl[i] = (bf16)(pk2(v - bf_lo(h), 0.f) & 0xffffu); } }
    { bf16* P16 = (bf16*)(ws + WS_P16); const float* p = KIN(1, (size_t)M * 256);
      for (int i = gt; i < M * 256 / 8; i += NGT) { const f32x4 a0 = ((const f32x4*)p)[2 * i], a1 = ((const f32x4*)p)[2 * i + 1];
        v4u o; o.x = pk2(a0[0], a0[1]); o.y = pk2(a0[2], a0[3]); o.z = pk2(a1[0], a1[1]); o.w = pk2(a1[2], a1[3]); ((v4u*)P16)[i] = o; } }
}
__device__ __forceinline__ void phase_cossin(kaptr ka) {
    const Tid T = get_tid(); unsigned char* ws = ka_ws(ka); const int gt = get_vcu() * 512 + T.tid, NGT = get_G() * 512;
    f32x2* cs = (f32x2*)(ws + WS_SMALL + SM_COSSIN); const int* pos = (const int*)ka_in(ka, 2);
    for (int i = gt; i < M * 16; i += NGT) { const int row = i >> 4, k = i & 15; const double ang = (double)pos[row] * pow(10000.0, -(double)k / 16.0); cs[i] = (f32x2){(float)cos(ang), (float)sin(ang)}; }
}
__device__ __forceinline__ void norm_row_bf16(const float* xrow, bf16* orow, int lane) {
    const f32x4* xr = (const f32x4*)xrow + lane;
    f32x4 v[4]; float s = 0.f;
#pragma unroll
    for (int j = 0; j < 4; ++j) { v[j] = xr[64 * j]; s += (v[j].x * v[j].x + v[j].y * v[j].y) + (v[j].z * v[j].z + v[j].w * v[j].w); }
    const float rstd = 1.f / sqrtf(wave_sum(s) * (1.f / D) + EPS);
    v2u* o8 = (v2u*)orow + lane;
#pragma unroll
    for (int j = 0; j < 4; ++j) { v2u w; w.x = pk2(v[j].x * rstd, v[j].y * rstd); w.y = pk2(v[j].z * rstd, v[j].w * rstd); o8[64 * j] = w; }
}
__device__ __forceinline__ void phase_n1(kaptr ka, int L) {
    const Tid T = get_tid(); const int gw = get_vcu() * NWAVES + T.wave, NGW = get_G() * NWAVES;
    const float* X = (L == 0) ? ka_in(ka, 0) : (const float*)ka_out(ka); bf16* XN = (bf16*)(ka_ws(ka) + WS_XN);
    for (int m = gw; m < M; m += NGW) norm_row_bf16(X + (size_t)m * D, XN + (size_t)m * D, T.lane);
}

__device__ __forceinline__ void phase_e1(kaptr ka, int L, LAS unsigned char* lds) {
    const Tid T = get_tid(); const int vcu = get_vcu(), G = get_G();
    unsigned char* ws = ka_ws(ka); unsigned char* R = ws + WS_R;
    const bf16* SCB = (const bf16*)(R + R_SCB); const bf16* CU = (const bf16*)(R + R_CU); const bf16* U = (const bf16*)(R + R_U);
    const bf16* QL = (const bf16*)(R + R_QL); const bf16* KVL = (const bf16*)(R + R_KVL); const bf16* KRR = (const bf16*)(R + R_KRR);
    bf16* KROPE = (bf16*)(R + R_KROPE); bf16* AIN = (bf16*)(R + R_AIN); bf16* CIN = (bf16*)(R + R_CIN);
    float* RSTDQ = (float*)(ws + WS_SMALL + SM_RSTDQ); float* RSTDKV = (float*)(ws + WS_SMALL + SM_RSTDKV);
    const f32x2* COSSIN = (const f32x2*)(ws + WS_SMALL + SM_COSSIN);
    const float* conv_c_w = KIN(12, 31 * 512); const float* conv_a_w = KIN(5, 3 * 512); const float* ln_c_g = KIN(13, 512); const float* ln_c_b = KIN(14, 512);
    LAS float* ldsf = (LAS float*)lds;
    const int tid = T.tid, cp = tid & 255, hb = tid >> 8, lane = T.lane;
    f32x2 w[31];
#pragma unroll
    for (int k = 0; k < 31; ++k) w[k] = *(const f32x2*)((const char*)conv_c_w + (unsigned)(k * 2048 + 8 * cp));
#pragma unroll 1
    for (int item = vcu; item < M / 64; item += G) {
        const int row0 = item * 64, t0 = row0 & (S - 1), seq0 = row0 - t0;
        {
            f32x2 acc[32];
#pragma unroll
            for (int j = 0; j < 32; ++j) acc[j] = (f32x2){0.f, 0.f};
            const int tb = t0 + 32 * hb - 30;
            const char* Useq = (const char*)(U + (size_t)seq0 * 512); const unsigned cp4 = 4u * cp;
#pragma unroll
            for (int rc = 0; rc < 64; rc += 16) {
                f32x2 uv[16]; int tbc = tb; asm volatile("" : "+v"(tbc));
#pragma unroll
                for (int q = 0; q < 16; ++q) { const int r = rc + q; if (r < 62) { const int tin = tbc + r; const int tcl = tin < 0 ? 0 : tin;
                        const unsigned v = *(const unsigned*)(Useq + ((unsigned)tcl * 1024u + cp4)); const float msk = tin < 0 ? 0.f : 1.f; uv[q] = (f32x2){bf_lo(v) * msk, bf_hi(v) * msk}; } }
#pragma unroll
                for (int q = 0; q < 16; ++q) { const int r = rc + q; if (r < 62) {
#pragma unroll
                        for (int j = 0; j < 32; ++j) { const int k = r - j; if (k >= 0 && k <= 30) acc[j] += w[k] * uv[q]; } } }
                asm volatile("" ::: "memory");
            }
#pragma unroll
            for (int j = 0; j < 32; ++j) *(LAS f32x2*)(ldsf + (32 * hb + j) * 512 + 2 * cp) = acc[j];
        }
        __syncthreads();
        {
            f32x4 g0 = *(const f32x4*)(ln_c_g + 8 * lane), g1 = *(const f32x4*)(ln_c_g + 8 * lane + 4), b0 = *(const f32x4*)(ln_c_b + 8 * lane), b1 = *(const f32x4*)(ln_c_b + 8 * lane + 4);
#pragma unroll 2
            for (int i = 0; i < 8; ++i) { const int tok = T.wave * 8 + i;
                f32x4 v0 = *(const LAS f32x4*)(ldsf + tok * 512 + 8 * lane), v1 = *(const LAS f32x4*)(ldsf + tok * 512 + 8 * lane + 4);
                const float mean = wave_sum((v0.x + v0.y) + (v0.z + v0.w) + (v1.x + v1.y) + (v1.z + v1.w)) * (1.f / 512.f);
                v0 = v0 - mean; v1 = v1 - mean;
                const float var = wave_sum((v0.x * v0.x + v0.y * v0.y) + (v0.z * v0.z + v0.w * v0.w) + (v1.x * v1.x + v1.y * v1.y) + (v1.z * v1.z + v1.w * v1.w)) * (1.f / 512.f);
                const float rstd = 1.f / sqrtf(var + EPS);
                v0 = v0 * rstd * g0 + b0; v1 = v1 * rstd * g1 + b1;
#pragma unroll
                for (int j = 0; j < 4; ++j) { v0[j] *= fsigmoid(v0[j]); v1[j] *= fsigmoid(v1[j]); }
                v4u o; o.x = pk2(v0.x, v0.y); o.y = pk2(v0.z, v0.w); o.z = pk2(v1.x, v1.y); o.w = pk2(v1.z, v1.w);
                *(v4u*)(CIN + (size_t)(row0 + tok) * 512 + 8 * lane) = o; }
        }
        {
            const f32x2 w0 = *(const f32x2*)(conv_a_w + 2 * cp), w1 = *(const f32x2*)(conv_a_w + 512 + 2 * cp), w2 = *(const f32x2*)(conv_a_w + 1024 + 2 * cp);
            const int tA = t0 + 32 * hb;
            f32x2 c2, c1;
            { const int ta = tA - 2, tb2 = tA - 1; const unsigned va = *(const unsigned*)(CU + (size_t)(seq0 + (ta < 0 ? 0 : ta)) * 512 + 2 * cp), vb = *(const unsigned*)(CU + (size_t)(seq0 + (tb2 < 0 ? 0 : tb2)) * 512 + 2 * cp);
              const float ma = ta < 0 ? 0.f : 1.f, mb = tb2 < 0 ? 0.f : 1.f; c2 = (f32x2){bf_lo(va) * ma, bf_hi(va) * ma}; c1 = (f32x2){bf_lo(vb) * mb, bf_hi(vb) * mb}; }
            const char* CUs = (const char*)(CU + (size_t)seq0 * 512); const char* SCBs = (const char*)(SCB + (size_t)seq0 * 512); char* AINs = (char*)(AIN + (size_t)seq0 * 512);
#pragma unroll 8
            for (int j = 0; j < 32; ++j) { const unsigned ro = (unsigned)(tA + j) * 1024u + 4u * cp;
                const unsigned vc = *(const unsigned*)(CUs + ro), vs = *(const unsigned*)(SCBs + ro);
                const f32x2 c0 = (f32x2){bf_lo(vc), bf_hi(vc)}; const f32x2 a = (w0 * c2 + w1 * c1 + w2 * c0) * (f32x2){bf_lo(vs), bf_hi(vs)};
                *(unsigned*)(AINs + ro) = pk2(a.x, a.y); c2 = c1; c1 = c0; }
        }
#pragma unroll
        for (int q = 0; q < 2; ++q) { const int idx = tid + 512 * q, tok = idx >> 4, i = idx & 15; const size_t row = row0 + tok;
            const float x1 = bf_lo((unsigned)KRR[row * 32 + i]), x2 = bf_lo((unsigned)KRR[row * 32 + 16 + i]); const f32x2 cs = COSSIN[row * 16 + i];
            KROPE[row * 32 + i] = (bf16)(pk2(x1 * cs.x - x2 * cs.y, 0.f) & 0xffffu); KROPE[row * 32 + 16 + i] = (bf16)(pk2(x1 * cs.y + x2 * cs.x, 0.f) & 0xffffu); }
#pragma unroll 2
        for (int i = 0; i < 8; ++i) { const size_t row = row0 + T.wave * 8 + i;
            const v2u* qp = (const v2u*)(QL + row * 768) + 3 * lane; float s = 0.f;
#pragma unroll
            for (int j = 0; j < 3; ++j) { const v2u w = qp[j]; const float a = bf_lo(w.x), b = bf_hi(w.x), c = bf_lo(w.y), d = bf_hi(w.y); s += (a * a + b * b) + (c * c + d * d); }
            const v2u kw = *((const v2u*)(KVL + row * 256) + lane); const float a = bf_lo(kw.x), b = bf_hi(kw.x), c = bf_lo(kw.y), d = bf_hi(kw.y);
            const float s2 = (a * a + b * b) + (c * c + d * d);
            const float sq = wave_sum(s), sk = wave_sum(s2);
            if (lane == 0) { RSTDQ[row] = 1.f / sqrtf(sq * (1.f / 768.f) + EPS); RSTDKV[row] = 1.f / sqrtf(sk * (1.f / 256.f) + EPS); } }
        __syncthreads();
    }
}

__device__ __forceinline__ void moe_tables(unsigned char* ws, int L, LAS unsigned char* lds) {
    LAS int* off = (LAS int*)(lds + LT_OFF); LAS int* tile = (LAS int*)(lds + LT_TILE); LAS int* ntp = (LAS int*)(lds + LT_NT);
    gu32* ctl = (gu32*)(ws + WS_CTL);
    __syncthreads();
    if (threadIdx.x == 0) { int o = 0, nt = 0;
#pragma unroll 1
        for (int e = 0; e < 32; ++e) { const int cnt = (int)__hip_atomic_load(ctl + CW_CNT + (L * 32 + e) * 16, RLX_AGENT); off[e] = o; const int n = (cnt + 255) >> 8;
#pragma unroll 1
            for (int k = 0; k < n && nt + k < MOE_TILES; ++k) tile[nt + k] = e;
            nt += n; o += n * 256; }
        off[32] = o; ntp[0] = nt < MOE_TILES ? nt : MOE_TILES; }
    __syncthreads();
}
__device__ __forceinline__ void phase_n2(kaptr ka, int L, LAS unsigned char* lds, int dry = 0) {
    typedef short bf16x8 __attribute__((ext_vector_type(8)));
    const Tid T = get_tid(); const int vcu = get_vcu(), G = get_G();
    unsigned char* ws = ka_ws(ka); gu32* ctl = (gu32*)(ws + WS_CTL);
    const float* X = ka_out(ka); bf16* XN = (bf16*)(ws + WS_XN); bf16* XLO = (bf16*)(ws + WS_R + R_Y);
    const bf16* WRh = (const bf16*)(ws + WS_W + WO_WR); const bf16* WRl = WRh + 48 * 1024;
    const float* b_rg = KIN(19, 4); const float* b_re = KIN(21, 32);
    int* SELE = (int*)(ws + WS_SMALL + SM_SELE); int* SELR = (int*)(ws + WS_SMALL + SM_SELR); float* WT = (float*)(ws + WS_SMALL + SM_WT); int* BASE = (int*)(ws + WS_SMALL + SM_BASE);
    LAS int* hist = (LAS int*)(lds + LT_HIST);
    LAS float* LG = (LAS float*)(lds + T.wave * 4096);
    const int lane = T.lane;
    __syncthreads();
    if (T.tid < 32) hist[T.tid] = 0;
    __syncthreads();
    if (T.wave < 4) for (int item = vcu * 4 + T.wave; item < M / 16; item += G * 4) {
        const int row0 = item * 16;
#pragma unroll 1
        for (int q = 0; q < 4; ++q) {
#pragma unroll
            for (int r = 0; r < 4; ++r) { const size_t row = row0 + 4 * q + r; const f32x4* xr = (const f32x4*)(X + row * D) + lane; f32x4 v[4]; float s = 0.f;
#pragma unroll
                for (int j = 0; j < 4; ++j) { v[j] = xr[64 * j]; s += (v[j].x * v[j].x + v[j].y * v[j].y) + (v[j].z * v[j].z + v[j].w * v[j].w); }
                const float rs = 1.f / sqrtf(wave_sum(s) * (1.f / D) + EPS);
                v2u* oh = (v2u*)(XN + row * D) + lane; v2u* ol = (v2u*)(XLO + row * D) + lane;
#pragma unroll
                for (int j = 0; j < 4; ++j) { const f32x4 y = v[j] * rs; v2u h, l; h.x = pk2(y.x, y.y); h.y = pk2(y.z, y.w);
                    l.x = pk2(y.x - bf_lo(h.x), y.y - bf_hi(h.x)); l.y = pk2(y.z - bf_lo(h.y), y.w - bf_hi(h.y)); oh[64 * j] = h; ol[64 * j] = l; } }
        }
        asm volatile("s_waitcnt vmcnt(0)" ::: "memory");
        f32x4 acc[3] = {(f32x4){0.f, 0.f, 0.f, 0.f}, (f32x4){0.f, 0.f, 0.f, 0.f}, (f32x4){0.f, 0.f, 0.f, 0.f}};
        { const int r = lane & 15, kq = lane >> 4;
          const bf16* ah = XN + (size_t)(row0 + r) * D + 8 * kq; const bf16* al = XLO + (size_t)(row0 + r) * D + 8 * kq;
          const bf16* bh = WRh + (size_t)r * 1024 + 8 * kq; const bf16* bl = WRl + (size_t)r * 1024 + 8 * kq;
#pragma unroll 4
          for (int s = 0; s < 32; ++s) { const bf16x8 Ah = *(const bf16x8*)(ah + 32 * s), Al = *(const bf16x8*)(al + 32 * s);
#pragma unroll
              for (int nt = 0; nt < 3; ++nt) { const bf16x8 Bh = *(const bf16x8*)(bh + nt * 16 * 1024 + 32 * s), Bl = *(const bf16x8*)(bl + nt * 16 * 1024 + 32 * s);
                  acc[nt] = __builtin_amdgcn_mfma_f32_16x16x32_bf16(Ah, Bh, acc[nt], 0, 0, 0); acc[nt] = __builtin_amdgcn_mfma_f32_16x16x32_bf16(Ah, Bl, acc[nt], 0, 0, 0); acc[nt] = __builtin_amdgcn_mfma_f32_16x16x32_bf16(Al, Bh, acc[nt], 0, 0, 0); } }
#pragma unroll
          for (int nt = 0; nt < 3; ++nt)
#pragma unroll
              for (int j = 0; j < 4; ++j) LG[(4 * kq + j) * 49 + nt * 16 + r] = acc[nt][j]; }
        LDS_WAIT(); asm volatile("" ::: "memory");
        if (lane < 16) { const LAS float* lg = LG + lane * 49;
            float gl[4]; float gm = -INFINITY; int gs = 0;
#pragma unroll
            for (int k = 0; k < 4; ++k) { gl[k] = lg[k] + b_rg[k]; if (gl[k] > gm) { gm = gl[k]; gs = k; } }
            float gsum = 0.f;
#pragma unroll
            for (int k = 0; k < 4; ++k) gsum += expf(gl[k] - gm);
            const float p_sel = 1.0f / gsum;
            float el[8]; float em = -INFINITY;
#pragma unroll
            for (int e = 0; e < 8; ++e) { el[e] = lg[4 + gs * 8 + e] + b_re[gs * 8 + e]; em = fmaxf(em, el[e]); }
            int i0 = 0; float p0 = -1.f;
#pragma unroll
            for (int e = 0; e < 8; ++e) { el[e] = expf(el[e] - em); if (el[e] > p0) { p0 = el[e]; i0 = e; } }
            int i1 = 0; float p1 = -1.f;
#pragma unroll
            for (int e = 0; e < 8; ++e) if (e != i0 && el[e] > p1) { p1 = el[e]; i1 = e; }
            if (!dry) { const int row = row0 + lane, e0 = gs * 8 + i0, e1 = gs * 8 + i1; const float tot = p0 + p1;
                SELE[row * 2] = e0; SELE[row * 2 + 1] = e1;
                SELR[row * 2] = __hip_atomic_fetch_add(&hist[e0], 1, __ATOMIC_RELAXED, __HIP_MEMORY_SCOPE_WORKGROUP); SELR[row * 2 + 1] = __hip_atomic_fetch_add(&hist[e1], 1, __ATOMIC_RELAXED, __HIP_MEMORY_SCOPE_WORKGROUP);
                WT[row * 2] = p0 / tot * p_sel; WT[row * 2 + 1] = p1 / tot * p_sel; } }
        LDS_WAIT(); asm volatile("" ::: "memory");
    }
    __syncthreads();
    if (T.tid < 32 && !dry) { const int c = hist[T.tid]; int base = 0; if (c > 0) base = (int)__hip_atomic_fetch_add(ctl + CW_CNT + (L * 32 + T.tid) * 16, (unsigned)c, RLX_AGENT); BASE[vcu * 32 + T.tid] = base; }
    __syncthreads();
}
__device__ __forceinline__ void phase_r1(kaptr ka, int L, LAS unsigned char* lds) {
    const Tid T = get_tid(); const int vcu = get_vcu(), G = get_G();
    unsigned char* ws = ka_ws(ka);
    const int* SELE = (const int*)(ws + WS_SMALL + SM_SELE); const int* SELR = (const int*)(ws + WS_SMALL + SM_SELR); const float* WT = (const float*)(ws + WS_SMALL + SM_WT);
    const int* BASE = (const int*)(ws + WS_SMALL + SM_BASE); int* TOKPOS = (int*)(ws + WS_SMALL + SM_TOKPOS); float* ROWW = (float*)(ws + WS_SMALL + SM_ROWW);
    const bf16* XN = (const bf16*)(ws + WS_XN); bf16* XG = (bf16*)(ws + WS_R + R_XG);
    moe_tables(ws, L, lds);
    const LAS int* off = (const LAS int*)(lds + LT_OFF);
    const int lane = T.lane;
    for (int it0 = vcu * 4; it0 < M / 16; it0 += G * 4) {
#pragma unroll 1
        for (int q = 0; q < 8; ++q) { const int row = it0 * 16 + q * 8 + T.wave; const v4u* src = (const v4u*)(XN + (size_t)row * D); const v4u a = src[lane], b = src[64 + lane];
#pragma unroll
            for (int s = 0; s < 2; ++s) { const int e = SELE[row * 2 + s]; int pos = off[e] + BASE[vcu * 32 + e] + SELR[row * 2 + s]; pos = pos < MOE_ROWS ? pos : MOE_ROWS - 1;
                v4u* dst = (v4u*)(XG + (size_t)pos * D); dst[lane] = a; dst[64 + lane] = b;
                if (lane == 0) { ROWW[pos] = WT[row * 2 + s]; TOKPOS[row * 2 + s] = pos; } } }
    }
}
__device__ __forceinline__ void phase_n3(kaptr ka, int dry = 0) {
    const Tid T = get_tid(); unsigned char* ws = ka_ws(ka); float* X = ka_out(ka); bf16* XN = (bf16*)(ws + WS_XN);
    const int* TOKPOS = (const int*)(ws + WS_SMALL + SM_TOKPOS); const bf16* Y = (const bf16*)(ws + WS_R + R_Y);
    const int lane = T.lane, gw = get_vcu() * NWAVES + T.wave, NGW = get_G() * NWAVES;
    for (int m = gw; m < M; m += NGW) {
        const int p0 = TOKPOS[m * 2], p1 = TOKPOS[m * 2 + 1];
        f32x4* xr = (f32x4*)(X + (size_t)m * D) + lane; const v2u* y0 = (const v2u*)(Y + (size_t)p0 * D) + lane; const v2u* y1 = (const v2u*)(Y + (size_t)p1 * D) + lane;
        f32x4 v[4]; float s = 0.f;
#pragma unroll
        for (int j = 0; j < 4; ++j) { const v2u a = y0[64 * j], b = y1[64 * j]; v[j] = xr[64 * j];
            v[j].x += bf_lo(a.x) + bf_lo(b.x); v[j].y += bf_hi(a.x) + bf_hi(b.x); v[j].z += bf_lo(a.y) + bf_lo(b.y); v[j].w += bf_hi(a.y) + bf_hi(b.y);
            if (!dry) xr[64 * j] = v[j]; s += (v[j].x * v[j].x + v[j].y * v[j].y) + (v[j].z * v[j].z + v[j].w * v[j].w); }
        const float rstd = 1.f / sqrtf(wave_sum(s) * (1.f / D) + EPS);
        v2u* o8 = (v2u*)(XN + (size_t)m * D) + lane;
#pragma unroll
        for (int j = 0; j < 4; ++j) { v2u w; w.x = pk2(v[j].x * rstd, v[j].y * rstd); w.y = pk2(v[j].z * rstd, v[j].w * rstd); o8[64 * j] = w; }
    }
}
__device__ __forceinline__ void phase_final(kaptr ka) {
    const Tid T = get_tid(); float* X = ka_out(ka); const float* g = ka_in(ka, 28);
    const int lane = T.lane, gw = get_vcu() * NWAVES + T.wave, NGW = get_G() * NWAVES;
    for (int m = gw; m < M; m += NGW) {
        f32x4* xr = (f32x4*)(X + (size_t)m * D) + lane; f32x4 v[4]; float s = 0.f;
#pragma unroll
        for (int j = 0; j < 4; ++j) { v[j] = xr[64 * j]; s += (v[j].x * v[j].x + v[j].y * v[j].y) + (v[j].z * v[j].z + v[j].w * v[j].w); }
        const float rstd = 1.f / sqrtf(wave_sum(s) * (1.f / D) + EPS);
#pragma unroll
        for (int j = 0; j < 4; ++j) xr[64 * j] = v[j] * rstd * ((const f32x4*)g)[64 * j + lane];
    }
}

#ifndef DUP_PHASE
#define DUP_PHASE -1
#endif
#define REP(k) _Pragma("unroll 1") for (int rep_ = 0; rep_ < ((k) == DUP_PHASE ? 2 : 1); ++rep_)
__device__ __forceinline__ bool in_range(int k) { kaptr ka = ka_get(); return ka_int(ka, 0) <= k && k < ka_int(ka, 1); }
constexpr int NPHASE = 13;
__global__ void __launch_bounds__(NWAVES * 64, 2) mk_fwd(Args args) {
    extern __shared__ __attribute__((aligned(16))) unsigned char lds_raw[];
    LAS unsigned char* lds = (LAS unsigned char*)lds_raw;
    for (int u = threadIdx.x; u < (LDS_BYTES - LDSCTL_OFF) / 4; u += NWAVES * 64) ((LAS unsigned*)(lds + LDSCTL_OFF))[u] = 0u;
    __syncthreads();
    XcdBarrier bar;
    { kaptr ka = ka_get(); bar = xcd_barrier_post((unsigned*)(ka_ws(ka) + WS_CTL) + CW_BAR + ka_int(ka, 4) * XCD_BAR_WORDS, (volatile LAS unsigned*)(lds + MISC_OFF) + 8); }
#define IN(k) in_range(k)
    { kaptr ka = ka_get(); if (ka_int(ka, 2) == 0 && ka_int(ka, 0) == 0) phase_cossin(ka); }
#define GRID_BAR() xcd_barrier(bar)
#define WPTR(off) ((const bf16*)(ws + WS_W + (off)))
#define RPTR(off) ((bf16*)(ws + WS_R + (off)))
    const int l_hi = args.l_hi;
#pragma unroll 1
    for (int L = args.l_lo; L < l_hi; ++L) {
        if (IN(0)) REP(0) { kaptr ka = ka_get(); phase_w(ka, L, lds); phase_n1(ka, L); GRID_BAR(); }
        if (IN(1)) REP(1) { kaptr ka = ka_get(); unsigned char* ws = ka_ws(ka);
            pg8::Gemm g{(const bf16*)(ws + WS_XN), WPTR(WO_IN), D, D, D}; pg8::StaticOrder S_; S_.init(M, INC_PAD, get_G(), get_bx());
            pg8::EpiInProj E{ws + WS_R}; pg8::gemm_phase<pg8::EpiInProj, pg8::StaticOrder>(lds, g, S_, E); GRID_BAR(); }
        if (IN(2)) REP(2) { kaptr ka = ka_get(); phase_e1(ka, L, lds); GRID_BAR(); }
        if (IN(3)) {
            { kaptr ka = ka_get(); unsigned char* ws = ka_ws(ka); pg8::Gemm g{RPTR(R_AIN), WPTR(WO_OUTA), 512, 512, 512}; pg8::StaticOrder S_; S_.init(M, D, get_G(), get_bx());
              pg8::EpiGateRmw<true> E{RPTR(R_SG), 0, 0}; pg8::gemm_phase<pg8::EpiGateRmw<true>, pg8::StaticOrder>(lds, g, S_, E); }
            { kaptr ka = ka_get(); unsigned char* ws = ka_ws(ka); pg8::Gemm g{RPTR(R_CIN), WPTR(WO_OUTC), 512, 512, 512}; pg8::StaticOrder S_; S_.init(M, D, get_G(), get_bx());
              pg8::EpiGateRmw<false> E{RPTR(R_SG), 2048, 0}; pg8::gemm_phase<pg8::EpiGateRmw<false>, pg8::StaticOrder>(lds, g, S_, E); }
            REP(32) { kaptr ka = ka_get(); unsigned char* ws = ka_ws(ka); pg8::Gemm g{RPTR(R_QL), WPTR(WO_UQ), 768, 768, 768}; pg8::StaticOrder S_; S_.init(M, 768, get_G(), get_bx());
              pg8::EpiQ E{ws}; pg8::gemm_phase<pg8::EpiQ, pg8::StaticOrder>(lds, g, S_, E); }
            REP(33) { kaptr ka = ka_get(); unsigned char* ws = ka_ws(ka); pg8::Gemm g{RPTR(R_KVL), WPTR(WO_UKV), 256, 256, 256}; pg8::StaticOrder S_; S_.init(M, 1024, get_G(), get_bx());
              pg8::EpiKV E{ws}; pg8::gemm_phase<pg8::EpiKV, pg8::StaticOrder>(lds, g, S_, E); }
            GRID_BAR(); }
        if (IN(4)) REP(4) { kaptr ka = ka_get(); unsigned char* ws = ka_ws(ka);
            const bf16* Qb = (const bf16*)(ws + WS_XN); const bf16* Kb = RPTR(R_SCB); const bf16* Vb = RPTR(R_CU); const bf16* Kr = RPTR(R_KROPE); bf16* AO = RPTR(R_AIN);
            for (int v = get_vcu(); v < 256; v += get_G()) { const int bh = v >> 2, s = v & 3;
                attn::attn_unit(bh >> 3, bh & 7, 7 - s, Qb, Kb, Kr, Vb, AO, (attn::lptr)lds);
                attn::attn_unit(bh >> 3, bh & 7, s, Qb, Kb, Kr, Vb, AO, (attn::lptr)lds); }
            GRID_BAR(); }
        if (IN(5)) REP(5) { kaptr ka = ka_get(); unsigned char* ws = ka_ws(ka); pg8::Gemm g{RPTR(R_AIN), WPTR(WO_OUTB), 512, 512, 512}; pg8::StaticOrder S_; S_.init(M, D, get_G(), get_bx());
            pg8::EpiGateRmw<false> E{RPTR(R_SG), 1024, rep_ ? 2048 : 0}; pg8::gemm_phase<pg8::EpiGateRmw<false>, pg8::StaticOrder>(lds, g, S_, E); GRID_BAR(); }
        if (IN(6)) REP(6) { kaptr ka = ka_get(); unsigned char* ws = ka_ws(ka); pg8::Gemm g{RPTR(R_SG), WPTR(WO_O), 3072, D, D}; pg8::StaticOrder S_; S_.init(M, D, get_G(), get_bx());
            float* Xs = ka_out(ka); pg8::EpiResF32 E{(L == 0) ? ka_in(ka, 0) : (const float*)Xs, rep_ ? (float*)(ws + WS_R + R_Y) : Xs}; pg8::gemm_phase<pg8::EpiResF32, pg8::StaticOrder>(lds, g, S_, E); GRID_BAR(); }
        if (IN(7)) REP(7) { kaptr ka = ka_get(); phase_n2(ka, L, lds, rep_); GRID_BAR(); }
        if (IN(8)) REP(8) { kaptr ka = ka_get(); phase_r1(ka, L, lds); GRID_BAR(); }
        if (IN(9)) REP(9) { kaptr ka = ka_get(); unsigned char* ws = ka_ws(ka); moe_tables(ws, L, lds); const int nt = *(const LAS int*)(lds + LT_NT);
            pg8::Gemm g{RPTR(R_XG), WPTR(WO_GU), D, D, D}; pg8::MoeOrder S_{(const LAS int*)(lds + LT_TILE), 2 * nt, 2, get_G(), get_bx()};
            pg8::EpiMoeGU E{ws}; pg8::gemm_phase<pg8::EpiMoeGU, pg8::MoeOrder>(lds, g, S_, E); GRID_BAR(); }
        if (IN(10)) REP(10) { kaptr ka = ka_get(); unsigned char* ws = ka_ws(ka); moe_tables(ws, L, lds); const int nt = *(const LAS int*)(lds + LT_NT);
            pg8::Gemm g{RPTR(R_H), WPTR(WO_DN), 256, 256, 256}; pg8::MoeOrder S_{(const LAS int*)(lds + LT_TILE), 4 * nt, 4, get_G(), get_bx()};
            pg8::EpiStoreBf16 E{RPTR(R_Y), D, 3}; pg8::gemm_phase<pg8::EpiStoreBf16, pg8::MoeOrder>(lds, g, S_, E); GRID_BAR(); }
        if (IN(11)) REP(11) { kaptr ka = ka_get(); phase_n3(ka, rep_); GRID_BAR(); }
        if (IN(12)) {
            REP(120) { kaptr ka = ka_get(); unsigned char* ws = ka_ws(ka); pg8::Gemm g{(const bf16*)(ws + WS_P16), WPTR(WO_PLE), 256, 256, 256}; pg8::StaticOrder S_; S_.init(M, D, get_G(), get_bx());
              pg8::EpiStoreBf16 E{RPTR(R_XG), D, 0xffff}; pg8::gemm_phase<pg8::EpiStoreBf16, pg8::StaticOrder>(lds, g, S_, E); }
            REP(121) { kaptr ka = ka_get(); unsigned char* ws = ka_ws(ka); pg8::Gemm g{(const bf16*)(ws + WS_XN), WPTR(WO_PG), D, D, D}; pg8::StaticOrder S_; S_.init(M, D, get_G(), get_bx());
              pg8::EpiPle E{ka_out(ka), ws, rep_ ? (float*)(ws + WS_R + R_Y) : ka_out(ka)}; pg8::gemm_phase<pg8::EpiPle, pg8::StaticOrder>(lds, g, S_, E); }
            GRID_BAR(); }
    }
    if (args.do_final) { kaptr ka = ka_get(); phase_final(ka); }
#undef IN
#undef GRID_BAR
#undef WPTR
#undef RPTR
}
#ifndef MK_CUT
#define MK_CUT 0
#endif
static void mk_launch(hipStream_t stream, int grid, Args a, int ph_lo, int ph_hi, int l_lo, int l_hi, int li, int do_final) {
    a.ph_lo = ph_lo; a.ph_hi = ph_hi; a.l_lo = l_lo; a.l_hi = l_hi; a.li = li; a.do_final = do_final;
    hipLaunchKernelGGL(mk_fwd, dim3(grid), dim3(NWAVES * 64), LDS_BYTES, stream, a);
}
extern "C" void kernel_launch(void* const* d_in, const int* in_sizes, int n_in, void* d_out, int out_size, void* d_ws, size_t ws_size, hipStream_t stream) {
    static int grid = 0;
    if (grid == 0) {
        if (n_in != 29 || out_size != M * D || ws_size < WS_END + 40 * MiB) { fprintf(stderr, "kernel_launch: unexpected shapes / workspace (%zu < %zu)\n", ws_size, (size_t)(WS_END + 40 * MiB)); grid = -1; return; }
        int dev = 0, cus = 0;
        if (hipGetDevice(&dev) != hipSuccess || hipDeviceGetAttribute(&cus, hipDeviceAttributeMultiprocessorCount, dev) != hipSuccess) { grid = -1; return; }
        if (hipFuncSetAttribute((const void*)mk_fwd, hipFuncAttributeMaxDynamicSharedMemorySize, LDS_BYTES) != hipSuccess) { grid = -1; return; }
        int per_cu = 0;
        if (hipOccupancyMaxActiveBlocksPerMultiprocessor(&per_cu, (const void*)mk_fwd, NWAVES * 64, LDS_BYTES) != hipSuccess || per_cu < 1) { fprintf(stderr, "kernel_launch: occupancy query says %d\n", per_cu); }
        (void)hipGetLastError();
        grid = cus;
    }
    if (grid < 0) return;
    (void)hipMemsetAsync((char*)d_ws + WS_CTL, 0, CTL_ZERO_BYTES, stream);
    Args a{};
    for (int i = 0; i < 29; ++i) a.in[i] = d_in[i];
    a.out = (float*)d_out; a.ws = (unsigned char*)d_ws;
#if defined(DUMP_K)
    mk_launch(stream, grid, a, 0, DUMP_K, 0, 1, 0, 0);
    hipLaunchKernelGGL(dbg_dump, dim3(M), dim3(256), 0, stream, (const unsigned char*)d_ws, (float*)d_out, (long long)DUMP_K);
#elif MK_CUT == 0
    mk_launch(stream, grid, a, 0, NPHASE, 0, DEPTH, 0, 1);
#elif MK_CUT == 3
    mk_launch(stream, grid, a, 0, NPHASE, 0, 1, 0, 0);
    mk_launch(stream, grid, a, 0, NPHASE, 1, 2, 1, 1);
#else
    {
        constexpr int MC = nv::MC;
        const float* p = (const float*)d_in[1];
        const float* ln_ffn_g = (const float*)d_in[17]; const float* w_rg = (const float*)d_in[18]; const float* b_rg = (const float*)d_in[19]; const float* w_re = (const float*)d_in[20]; const float* b_re = (const float*)d_in[21];
        const float* w_eg = (const float*)d_in[22]; const float* w_eu = (const float*)d_in[23]; const float* w_ed = (const float*)d_in[24];
        const float* ln_ple_g = (const float*)d_in[25]; const float* w_pg = (const float*)d_in[26]; const float* w_ple = (const float*)d_in[27]; const float* final_g = (const float*)d_in[28];
        float* X = (float*)d_out;
        float* nws = (float*)((char*)d_ws + WS_END);
        float* HN = nws; float* MG = HN + (size_t)MC * D; int* SEL = (int*)(MG + (size_t)MC * D); float* WTS = (float*)(SEL + MC * 2);
        for (int L = 0; L < DEPTH; ++L) {
            mk_launch(stream, grid, a, 0, MK_CUT == 1 ? 7 : 12, L, L + 1, L, 0);
            for (int c0 = 0; c0 < M; c0 += MC) {
                float* Xc = X + (size_t)c0 * D;
#if MK_CUT == 1
                hipLaunchKernelGGL(nv::rmsnorm_rows, dim3(MC), dim3(256), 0, stream, (const float*)Xc, (long long)D, (long long)D, ln_ffn_g + L * D, HN, (long long)D);
                hipLaunchKernelGGL(nv::route, dim3(MC), dim3(64), 0, stream, (const float*)HN, w_rg + (size_t)L * D * 4, b_rg + L * 4, w_re + (size_t)L * D * 32, b_re + L * 32, SEL, WTS);
                hipLaunchKernelGGL(nv::moe_tok, dim3(MC), dim3(256), 0, stream, (const float*)HN, (const int*)SEL, (const float*)WTS,
                                   w_eg + (size_t)L * 32 * D * 256, w_eu + (size_t)L * 32 * D * 256, w_ed + (size_t)L * 32 * 256 * D, Xc);
#endif
                hipLaunchKernelGGL(nv::rmsnorm_rows, dim3(MC), dim3(256), 0, stream, (const float*)Xc, (long long)D, (long long)D, ln_ple_g + L * D, HN, (long long)D);
                nv::launch_gemm(stream, HN, D, w_pg + (size_t)L * D * D, D, MC, D, D, nv::EStore{MG, D});
                nv::launch_gemm(stream, p + ((size_t)L * M + c0) * 256, 256, w_ple + (size_t)L * 256 * D, D, MC, D, 256, nv::EPle{Xc, MG});
            }
        }
        for (int c0 = 0; c0 < M; c0 += MC) { float* Xc = X + (size_t)c0 * D;
            hipLaunchKernelGGL(nv::rmsnorm_rows, dim3(MC), dim3(256), 0, stream, (const float*)Xc, (long long)D, (long long)D, final_g, Xc, (long long)D); }
    }
#endif
}
```
